# Optimizing an MI355X kernel written in HIP

```python
import jax
import jax.numpy as jnp
from jax import lax
import numpy as np

D_MODEL = 2048
BATCH = 2
SEQ = 4096
DEPTH = 1

RET_HEADS = 4
RET_DV = D_MODEL // RET_HEADS
RET_DK = RET_DV // 2
RET_CHUNK = 256
RET_THETA = 10000.0
ATT_HEAD_DIM = 64
ATT_HEADS = D_MODEL // ATT_HEAD_DIM
ATT_KV_HEADS = ATT_HEADS // 8
WINDOW = 128
ATT_BLOCK = WINDOW
ROPE_THETA = 500000.0
ROPE_DIM = ATT_HEAD_DIM // 4
D_FF = ((-(-8 * D_MODEL // 3) + 255) // 256) * 256
DEEPNORM_ALPHA = (2.0 * DEPTH) ** 0.25
DEEPNORM_BETA = (8.0 * DEPTH) ** -0.25
LN_EPS = 1e-5
GN_EPS = 1e-5

kernel_name = 'hybrid_retention_swa_sink_deepnorm'


def _in_proj_sizes():
    return (RET_HEADS * RET_DK, RET_HEADS * RET_DK, RET_HEADS * RET_DV, RET_HEADS * RET_DV,
            ATT_HEADS * ATT_HEAD_DIM, ATT_KV_HEADS * ATT_HEAD_DIM, ATT_KV_HEADS * ATT_HEAD_DIM,
            D_MODEL, D_MODEL)


def _in_proj_scales():
    b = DEEPNORM_BETA
    return (1.0, 1.0, b, 1.0, 1.0, 1.0, b, 1.0, 1.0)


def layer_norm(x, g, b):
    xf = x.astype(jnp.float32)
    mu = jnp.mean(xf, axis=-1, keepdims=True)
    var = jnp.mean(jnp.square(xf - mu), axis=-1, keepdims=True)
    return ((xf - mu) * lax.rsqrt(var + LN_EPS)).astype(x.dtype) * g + b


def rotary_tables(positions, inv_freq, dtype):
    ang = positions.astype(jnp.float32)[..., None] * inv_freq
    return (jnp.cos(ang)[:, :, None, :].astype(dtype),
            jnp.sin(ang)[:, :, None, :].astype(dtype))


def apply_rotary(x, cos, sin):
    x1, x2 = jnp.split(x, 2, axis=-1)
    return jnp.concatenate([x1 * cos - x2 * sin, x2 * cos + x1 * sin], axis=-1)


def retention_branch(q, k, v, g, gn_g, gn_b, positions):
    bsz, seq, nh, dk = q.shape
    dv = v.shape[-1]
    inv_freq = 1.0 / (RET_THETA ** jnp.linspace(0.0, 1.0, dk // 2, dtype=jnp.float32))
    cos, sin = rotary_tables(positions, inv_freq, q.dtype)
    q = apply_rotary(q, cos, sin) * (dk ** -0.5)
    k = apply_rotary(k, cos, sin)
    log_gamma = jnp.log(1.0 - jnp.exp2(-5.0 - jnp.arange(nh, dtype=jnp.float32)))
    c = RET_CHUNK
    n = seq // c
    qc = q.reshape(bsz, n, c, nh, dk)
    kc = k.reshape(bsz, n, c, nh, dk)
    vc = v.reshape(bsz, n, c, nh, dv)
    idx = jnp.arange(c, dtype=jnp.float32)
    diff = idx[:, None] - idx[None, :]
    intra_decay = jnp.where(diff >= 0.0,
                            jnp.exp(log_gamma[:, None, None] * jnp.maximum(diff, 0.0)), 0.0)
    s = jnp.einsum('bnchd,bnmhd->bnhcm', qc, kc) * intra_decay.astype(q.dtype)
    inner = jnp.einsum('bnhcm,bnmhe->bnche', s, vc)
    k_decay = jnp.exp(log_gamma[:, None] * (c - 1.0 - idx)[None, :])
    q_decay = jnp.exp(log_gamma[:, None] * (idx + 1.0)[None, :])
    chunk_decay = jnp.exp(log_gamma * c)[None, :, None, None]
    kv = jnp.einsum('bnmhd,hm,bnmhe->nbhde', kc.astype(jnp.float32), k_decay,
                    vc.astype(jnp.float32))

    def step(state, kv_chunk):
        return state * chunk_decay + kv_chunk, state

    _, prev = lax.scan(step, jnp.zeros(kv.shape[1:], jnp.float32), kv)
    cross = jnp.einsum('bnchd,hc,nbhde->bnche', qc.astype(jnp.float32), q_decay, prev)
    y = (inner.astype(jnp.float32) + cross).reshape(bsz, seq, nh, dv)
    mu = jnp.mean(y, axis=-1, keepdims=True)
    var = jnp.mean(jnp.square(y - mu), axis=-1, keepdims=True)
    y = ((y - mu) * lax.rsqrt(var + GN_EPS)).reshape(bsz, seq, nh * dv).astype(v.dtype)
    y = y * gn_g + gn_b
    return jax.nn.silu(g) * y


def sliding_window_sink_attention(q, k, v, sinks, positions):
    bsz, seq, hq, d = q.shape
    hkv = k.shape[2]
    grp = hq // hkv
    inv_freq = 1.0 / (ROPE_THETA ** (jnp.arange(0, ROPE_DIM, 2, dtype=jnp.float32) / ROPE_DIM))
    cos, sin = rotary_tables(positions, inv_freq, q.dtype)
    q = jnp.concatenate([apply_rotary(q[..., :ROPE_DIM], cos, sin), q[..., ROPE_DIM:]], axis=-1)
    k = jnp.concatenate([apply_rotary(k[..., :ROPE_DIM], cos, sin), k[..., ROPE_DIM:]], axis=-1)
    bq = ATT_BLOCK
    n = seq // bq
    qb = q.reshape(bsz, n, bq, hkv, grp, d)
    kb = k.reshape(bsz, n, bq, hkv, d)
    vb = v.reshape(bsz, n, bq, hkv, d)
    kpad = jnp.zeros_like(kb[:, :1])
    vpad = jnp.zeros_like(vb[:, :1])
    kw = jnp.concatenate([jnp.concatenate([kpad, kb[:, :-1]], axis=1), kb], axis=2)
    vw = jnp.concatenate([jnp.concatenate([vpad, vb[:, :-1]], axis=1), vb], axis=2)
    s = jnp.einsum('bnqhgd,bnkhd->bnhgqk', qb, kw).astype(jnp.float32) * (d ** -0.5)
    qi = jnp.arange(bq)[:, None]
    kj = jnp.arange(2 * bq)[None, :]
    dist = qi + bq - kj
    band = (dist >= 0) & (dist < WINDOW)
    valid = (jnp.arange(n)[:, None, None] > 0) | (kj[None] >= bq)
    mask = band[None] & valid
    s = jnp.where(mask[None, :, None, None], s, -jnp.inf)
    sink = sinks.astype(jnp.float32).reshape(hkv, grp)[:, :, None, None]
    m = jnp.maximum(jnp.max(s, axis=-1, keepdims=True), sink)
    p = jnp.exp(s - m)
    p = p / (jnp.sum(p, axis=-1, keepdims=True) + jnp.exp(sink - m))
    o = jnp.einsum('bnhgqk,bnkhd->bnqhgd', p.astype(v.dtype), vw)
    return o.reshape(bsz, seq, hq * d)


def setup_inputs(seed: int = 0) -> dict:
    key = jax.random.key(seed)
    ks = jax.random.split(key, 16)
    f32 = jnp.float32
    x = jax.random.normal(ks[0], (BATCH, SEQ, D_MODEL), f32)
    start = jax.random.randint(ks[1], (BATCH, 1), 0, 1024, dtype=jnp.int32)
    positions = start + jnp.arange(SEQ, dtype=jnp.int32)[None, :]
    sizes = _in_proj_sizes()
    scales = _in_proj_scales()
    seg_keys = jax.random.split(ks[2], len(sizes))
    w_in = jnp.concatenate(
        [jax.random.normal(sk, (DEPTH, D_MODEL, sz), f32) * (D_MODEL ** -0.5 * sc)
         for sk, sz, sc in zip(seg_keys, sizes, scales)], axis=-1)
    ret_gn_g = 1.0 + 0.02 * jax.random.normal(ks[3], (DEPTH, RET_HEADS * RET_DV), f32)
    ret_gn_b = 0.02 * jax.random.normal(ks[4], (DEPTH, RET_HEADS * RET_DV), f32)
    att_sinks = 0.5 * jax.random.normal(ks[5], (DEPTH, ATT_HEADS), f32)
    w_out = jax.random.normal(ks[6], (DEPTH, D_MODEL, D_MODEL), f32) * (D_MODEL ** -0.5 * DEEPNORM_BETA)
    ln1_g = 1.0 + 0.02 * jax.random.normal(ks[7], (DEPTH, D_MODEL), f32)
    ln1_b = 0.02 * jax.random.normal(ks[8], (DEPTH, D_MODEL), f32)
    w_gate = jax.random.normal(ks[9], (DEPTH, D_MODEL, D_FF), f32) * (D_MODEL ** -0.5 * DEEPNORM_BETA)
    w_up = jax.random.normal(ks[10], (DEPTH, D_MODEL, D_FF), f32) * (D_MODEL ** -0.5 * DEEPNORM_BETA)
    w_down = jax.random.normal(ks[11], (DEPTH, D_FF, D_MODEL), f32) * (D_FF ** -0.5 * DEEPNORM_BETA)
    ln2_g = 1.0 + 0.02 * jax.random.normal(ks[12], (DEPTH, D_MODEL), f32)
    ln2_b = 0.02 * jax.random.normal(ks[13], (DEPTH, D_MODEL), f32)
    return {'x': x, 'positions': positions, 'w_in': w_in, 'ret_gn_g': ret_gn_g,
            'ret_gn_b': ret_gn_b, 'att_sinks': att_sinks, 'w_out': w_out,
            'ln1_g': ln1_g, 'ln1_b': ln1_b, 'w_gate': w_gate, 'w_up': w_up,
            'w_down': w_down, 'ln2_g': ln2_g, 'ln2_b': ln2_b}


def reference(x, positions, w_in, ret_gn_g, ret_gn_b, att_sinks, w_out, ln1_g, ln1_b,
              w_gate, w_up, w_down, ln2_g, ln2_b):
    bsz, seq, _ = x.shape
    splits = np.cumsum(_in_proj_sizes())[:-1].tolist()
    h = x
    for l in range(DEPTH):
        proj = h @ w_in[l]
        rq, rk, rv, rg, aq, ak, av, gate_a, gate_b = jnp.split(proj, splits, axis=-1)
        ret = retention_branch(rq.reshape(bsz, seq, RET_HEADS, RET_DK),
                               rk.reshape(bsz, seq, RET_HEADS, RET_DK),
                               rv.reshape(bsz, seq, RET_HEADS, RET_DV),
                               rg, ret_gn_g[l], ret_gn_b[l], positions)
        att = sliding_window_sink_attention(aq.reshape(bsz, seq, ATT_HEADS, ATT_HEAD_DIM),
                                            ak.reshape(bsz, seq, ATT_KV_HEADS, ATT_HEAD_DIM),
                                            av.reshape(bsz, seq, ATT_KV_HEADS, ATT_HEAD_DIM),
                                            att_sinks[l], positions)
        merged = jax.nn.sigmoid(gate_a) * ret + jax.nn.sigmoid(gate_b) * att
        h = layer_norm(DEEPNORM_ALPHA * h + merged @ w_out[l], ln1_g[l], ln1_b[l])
        ffn = (jax.nn.silu(h @ w_gate[l]) * (h @ w_up[l])) @ w_down[l]
        h = layer_norm(DEEPNORM_ALPHA * h + ffn, ln2_g[l], ln2_b[l])
    return h
```

```cpp
#include <hip/hip_runtime.h>
#include <hip/hip_cooperative_groups.h>
#include <cstdio>
#include <cstdint>
namespace cg = cooperative_groups;
namespace pg8 {
#define PG8_LAS __attribute__((address_space(3)))
typedef unsigned short bf16_t;
typedef short bf16x8 __attribute__((ext_vector_type(8)));
typedef float f32x4 __attribute__((ext_vector_type(4)));
typedef unsigned u32x4 __attribute__((ext_vector_type(4)));
constexpr int BM = 256, BK = 64, HALF = 128, HTB = HALF * BK * 2  , STAGE_BYTES = 8 * HTB, NXCD = 8, WGM = 8;

__host__ __device__ __forceinline__ int lds_byte(int r, int c) { const int st = (r >> 4) * 2 + (c >> 5), rr = r & 15, cc = c & 31, ob = rr * 64 + cc * 2; return st * 1024 + (ob ^ (((ob >> 9) & 1) << 5)); }
__host__ __device__ __forceinline__ void stage_rc(int b, int& R, int& C) { const int st = b / 1024, sb = b % 1024, swz = sb ^ (((sb >> 9) & 1) << 5); R = (st >> 1) * 16 + swz / 64; C = (st & 1) * 32 + (swz % 64) / 2; }
__host__ __device__ __forceinline__ int perm32(int rho) { const int n = rho >> 4, i = rho & 15; return 8 * (i >> 2) + 4 * n + (i & 3); }

struct Unit { int pm, pn; };
struct Gemm { const bf16_t* A; const bf16_t* Bt; int M, N, K; };

struct StaticOrder {
    int nM, nN, nwg, G, c;
    __host__ __device__ void init(int M, int N, int G_, int c_) { nM = M / BM; nN = N / BM; nwg = nM * nN; G = G_; c = c_; }
    __host__ __device__ bool next(int i, Unit& u) const {
        const long L = (long)i * G + c; if (L >= nwg) return false;
        int wgid = (int)L; { const int q = nwg / NXCD, r = nwg % NXCD, xcd = wgid % NXCD, off = wgid / NXCD; wgid = (xcd < r ? xcd * (q + 1) : r * (q + 1) + (xcd - r) * q) + off; }
        const int nig = WGM * nN, gid = wgid / nig, fm = gid * WGM, gsz = (nM - fm) < WGM ? (nM - fm) : WGM;
        u.pm = fm + ((wgid % nig) % gsz); u.pn = (wgid % nig) / gsz; return true;
    }
    __device__ __forceinline__ void a_ready(const Unit&) const {}
    __device__ __forceinline__ void done(const Unit&) const {}
};

__device__ __forceinline__ unsigned cvt_pk_bf16(float lo, float hi) { unsigned r; asm volatile("v_cvt_pk_bf16_f32 %0, %1, %2" : "=v"(r) : "v"(lo), "v"(hi)); return r; }
typedef float f32x2 __attribute__((ext_vector_type(2)));
__device__ __forceinline__ float sigmoidf_(float x) { return __builtin_amdgcn_rcpf(1.0f + __expf(-x)); }
struct EpiInProj {
    static constexpr bool PERM = true, AFTER_DRAIN = false;
    bf16_t* O; const float* tabR; const float* tabA;
    __device__ __forceinline__ void operator()(const f32x4 (&acc)[2][2][4][2], const Unit& u, int wr, int wc, int fr, int fq) const {
        const int pn = u.pn, ldc = 12800;
        const int row0 = u.pm * BM + wr * 64 + fr, col0 = pn * BM + wc * 32 + 8 * fq;
        int mode; float sc = 1.f;
        if (pn < 4) { mode = 1; sc = 0.0625f; } else if (pn < 8) { mode = 1; } else if (pn < 16) { mode = 0; } else if (pn < 24) { mode = 2; }
        else if (pn < 32) { mode = 3; sc = 0.18033688011112042f; } else if (pn == 32) { mode = 3; } else if (pn == 33) { mode = 0; } else { mode = 4; }
        const bool arot = (mode == 3) && ((wc & 1) == 0) && (fq < 2);
#pragma unroll
        for (int ai = 0; ai < 2; ++ai)
#pragma unroll
            for (int m = 0; m < 4; ++m) { const int row = row0 + ai * HALF + m * 16; bf16_t* rowp = O + (size_t)row * ldc + col0;
#pragma unroll
                for (int bj = 0; bj < 2; ++bj) { f32x4 v0 = acc[ai][bj][m][0], v1 = acc[ai][bj][m][1];
                    if (mode == 1 || arot) {
                        f32x4 c4, s4;
                        if (mode == 1) { const float* t = tabR + (size_t)row * 256 + 64 * bj + 16 * wc + 4 * fq; c4 = *(const f32x4*)t; s4 = *(const f32x4*)(t + 128); }
                        else { const float* t = tabA + (size_t)row * 16 + 4 * fq; c4 = *(const f32x4*)t; s4 = *(const f32x4*)(t + 8); }
                        f32x4 w0, w1;
                        w0[0] = v0[0] * c4[0] - v0[1] * s4[0]; w0[1] = v0[1] * c4[0] + v0[0] * s4[0];
                        w0[2] = v0[2] * c4[1] - v0[3] * s4[1]; w0[3] = v0[3] * c4[1] + v0[2] * s4[1];
                        w1[0] = v1[0] * c4[2] - v1[1] * s4[2]; w1[1] = v1[1] * c4[2] + v1[0] * s4[2];
                        w1[2] = v1[2] * c4[3] - v1[3] * s4[3]; w1[3] = v1[3] * c4[3] + v1[2] * s4[3];
                        v0 = w0; v1 = w1;
                    }
                    if (mode == 2) {
#pragma unroll
                        for (int i = 0; i < 4; ++i) { v0[i] = v0[i] * sigmoidf_(v0[i]); v1[i] = v1[i] * sigmoidf_(v1[i]); } }
                    if (mode == 4) {
#pragma unroll
                        for (int i = 0; i < 4; ++i) { v0[i] = sigmoidf_(v0[i]); v1[i] = sigmoidf_(v1[i]); } }
                    v0 = v0 * sc; v1 = v1 * sc;
                    u32x4 w; w.x = cvt_pk_bf16(v0[0], v0[1]); w.y = cvt_pk_bf16(v0[2], v0[3]); w.z = cvt_pk_bf16(v1[0], v1[1]); w.w = cvt_pk_bf16(v1[2], v1[3]);
                    *(u32x4*)(rowp + bj * HALF) = w; } }
    }
};
struct EpiResF32 {
    static constexpr bool PERM = false, AFTER_DRAIN = false;
    const float* base; float* out; int ldc; float alpha;
    __device__ __forceinline__ void operator()(const f32x4 (&acc)[2][2][4][2], const Unit& u, int wr, int wc, int fr, int fq) const {
        const int col0 = u.pn * BM + wc * 32 + 4 * fq;
#pragma unroll
        for (int ai = 0; ai < 2; ++ai)
#pragma unroll
            for (int m = 0; m < 4; ++m) { const size_t off = (size_t)(u.pm * BM + ai * HALF + wr * 64 + m * 16 + fr) * ldc + col0;
#pragma unroll
                for (int bj = 0; bj < 2; ++bj)
#pragma unroll
                    for (int n = 0; n < 2; ++n) { const f32x4 bs = *(const f32x4*)(base + off + bj * HALF + n * 16); *(f32x4*)(out + off + bj * HALF + n * 16) = bs * alpha + acc[ai][bj][m][n]; } }
    }
};
struct EpiSwiGLU {
    static constexpr bool PERM = true, AFTER_DRAIN = false;
    bf16_t* O; int ldc;
    __device__ __forceinline__ void operator()(const f32x4 (&acc)[2][2][4][2], const Unit& u, int wr, int wc, int fr, int fq) const {
        const int row0 = u.pm * BM + wr * 64 + fr, col0 = u.pn * HALF + wc * 32 + 8 * fq;
#pragma unroll
        for (int ai = 0; ai < 2; ++ai)
#pragma unroll
            for (int m = 0; m < 4; ++m) { bf16_t* rowp = O + (size_t)(row0 + ai * HALF + m * 16) * ldc + col0;
                f32x4 g0 = acc[ai][0][m][0], g1 = acc[ai][0][m][1]; const f32x4 u0 = acc[ai][1][m][0], u1 = acc[ai][1][m][1];
#pragma unroll
                for (int i = 0; i < 4; ++i) { g0[i] = g0[i] * sigmoidf_(g0[i]) * u0[i]; g1[i] = g1[i] * sigmoidf_(g1[i]) * u1[i]; }
                u32x4 w; w.x = cvt_pk_bf16(g0[0], g0[1]); w.y = cvt_pk_bf16(g0[2], g0[3]); w.z = cvt_pk_bf16(g1[0], g1[1]); w.w = cvt_pk_bf16(g1[2], g1[3]);
                *(u32x4*)rowp = w; }
    }
};
template <class Epi, class Sched, bool ALIGN_EPI = false, bool SP2 = false>
__device__ __forceinline__ void gemm_phase(PG8_LAS unsigned char* lds, const Gemm g, const Sched& S, const Epi& E) {
    const int tid = threadIdx.x, wid = __builtin_amdgcn_readfirstlane(tid >> 6), lane = tid & 63, wr = wid >> 2, wc = wid & 3, fr = lane & 15, fq = lane >> 4;
    const int K = g.K, nt = K / BK;
    unsigned voffA[2], voffB[2];
#pragma unroll
    for (int i = 0; i < 2; ++i) { int R, C; stage_rc(tid * 16 + i * 8192, R, C); const int Rb = Epi::PERM ? ((R & ~31) + perm32(R & 31)) : R;
        voffA[i] = (unsigned)(R * K + C) * 2u; voffB[i] = (unsigned)(Rb * K + C) * 2u; }
    const size_t kstep = (size_t)(BK * 2);
    const size_t hstep = (size_t)HALF * K * 2;
    const size_t tstep = 2 * hstep;
    const unsigned ldsw = (unsigned)wid * 1024u;
    const int aoff = lds_byte(wr * 64 + fr, fq * 8), boff = lds_byte(wc * 32 + fr, fq * 8);
#define PG8_SA(b, h) (((b) * 2 + (h)) * HTB)
#define PG8_SB(b, h) ((4 + (b) * 2 + (h)) * HTB)
#define PG8_STAGE(bufoff, gbase, voff) do { _Pragma("unroll") for (int _i = 0; _i < 2; ++_i) \
        __builtin_amdgcn_global_load_lds((const unsigned*)((const char*)(gbase) + (voff)[_i]), (PG8_LAS unsigned*)(lds + (bufoff) + ldsw + _i * 8192), 16, 0, 0); } while (0)
#define PG8_LDA(dst, b, h) do { _Pragma("unroll") for (int m = 0; m < 4; ++m) _Pragma("unroll") for (int k = 0; k < 2; ++k) dst[m][k] = *(const PG8_LAS bf16x8*)(lds + PG8_SA(b, h) + aoff + m * 2048 + k * 1024); } while (0)
#define PG8_LDB(dst, b, h) do { _Pragma("unroll") for (int n = 0; n < 2; ++n) _Pragma("unroll") for (int k = 0; k < 2; ++k) dst[n][k] = *(const PG8_LAS bf16x8*)(lds + PG8_SB(b, h) + boff + n * 2048 + k * 1024); } while (0)
#define PG8_MMA(ai, bj, At, Bt) do { __builtin_amdgcn_s_setprio(1); _Pragma("unroll") for (int m = 0; m < 4; ++m) _Pragma("unroll") for (int n = 0; n < 2; ++n) _Pragma("unroll") for (int k = 0; k < 2; ++k) \
        acc[ai][bj][m][n] = __builtin_amdgcn_mfma_f32_16x16x32_bf16(Bt[n][k], At[m][k], acc[ai][bj][m][n], 0, 0, 0); __builtin_amdgcn_s_setprio(0); } while (0)
#define PG8_WAIT_V(n) asm volatile("s_waitcnt vmcnt(" #n ")" ::: "memory")
#define PG8_WAIT_L(n) asm volatile("s_waitcnt lgkmcnt(" #n ")" ::: "memory")
#define PG8_BAR __builtin_amdgcn_s_barrier()
#define PG8_SCHED __builtin_amdgcn_sched_barrier(0)
    Unit cur, nxt; int ui = 0;
    if (!S.next(0, cur)) return;
    f32x4 acc[2][2][4][2];
#pragma unroll
    for (int a = 0; a < 2; ++a)
#pragma unroll
        for (int b = 0; b < 2; ++b)
#pragma unroll
            for (int m = 0; m < 4; ++m)
#pragma unroll
                for (int n = 0; n < 2; ++n) acc[a][b][m][n] = (f32x4){0.f, 0.f, 0.f, 0.f};
    bf16x8 At[4][2], B0[2][2], B1[2][2];
    const char* cA = (const char*)g.A + (size_t)cur.pm * tstep; const char* cB = (const char*)g.Bt + (size_t)cur.pn * tstep;
    S.a_ready(cur);
    if constexpr (SP2) {
        PG8_STAGE(PG8_SB(0, 0), cB, voffB); PG8_STAGE(PG8_SB(0, 1), cB + hstep, voffB); PG8_STAGE(PG8_SA(0, 0), cA, voffA); PG8_STAGE(PG8_SA(0, 1), cA + hstep, voffA);
        if (wr == 1) PG8_BAR;
        PG8_WAIT_V(2); PG8_BAR;
        PG8_STAGE(PG8_SB(1, 0), cB + kstep, voffB); PG8_STAGE(PG8_SA(1, 0), cA + kstep, voffA); PG8_STAGE(PG8_SB(1, 1), cB + hstep + kstep, voffB);
        PG8_WAIT_V(6); PG8_BAR;
    } else {
        PG8_STAGE(PG8_SB(0, 0), cB, voffB); PG8_STAGE(PG8_SA(0, 0), cA, voffA); PG8_STAGE(PG8_SB(0, 1), cB + hstep, voffB); PG8_STAGE(PG8_SA(0, 1), cA + hstep, voffA);
        if (wr == 1) PG8_BAR;
        PG8_WAIT_V(4); PG8_BAR;
        PG8_STAGE(PG8_SB(1, 0), cB + kstep, voffB); PG8_STAGE(PG8_SA(1, 0), cA + kstep, voffA); PG8_STAGE(PG8_SB(1, 1), cB + hstep + kstep, voffB);
        PG8_WAIT_V(6); PG8_BAR;
    }
    for (;;) {
        const bool has_next = S.next(ui + 1, nxt);
        const char* nA = has_next ? (const char*)g.A + (size_t)nxt.pm * tstep : cA; const char* nB = has_next ? (const char*)g.Bt + (size_t)nxt.pn * tstep : cB;
        for (int t = 0; t < nt; t += 2) {
            const bool last = (t == nt - 2);
            const char* a1 = cA + (size_t)(t + 1) * kstep;
            const char* a2 = last ? nA : cA + (size_t)(t + 2) * kstep; const char* b2 = last ? nB : cB + (size_t)(t + 2) * kstep;
            const char* a3 = a2 + kstep; const char* b3 = b2 + kstep;
            if (last && has_next) S.a_ready(nxt);
            if constexpr (SP2) {
            PG8_LDB(B0, 0, 0); PG8_LDB(B1, 0, 1); PG8_SCHED; PG8_LDA(At, 0, 0); PG8_STAGE(PG8_SA(1, 1), a1 + hstep, voffA);
            PG8_WAIT_V(8); PG8_WAIT_L(0); PG8_BAR; PG8_MMA(0, 0, At, B0); PG8_MMA(0, 1, At, B1); PG8_BAR; PG8_SCHED;
            PG8_LDA(At, 0, 1); PG8_STAGE(PG8_SB(0, 0), b2, voffB); PG8_STAGE(PG8_SB(0, 1), b2 + hstep, voffB); PG8_STAGE(PG8_SA(0, 0), a2, voffA);
            PG8_WAIT_V(8); PG8_WAIT_L(0); PG8_BAR; PG8_MMA(1, 0, At, B0); PG8_MMA(1, 1, At, B1); PG8_BAR; PG8_SCHED;
            PG8_LDB(B0, 1, 0); PG8_LDB(B1, 1, 1); PG8_SCHED; PG8_LDA(At, 1, 0); PG8_STAGE(PG8_SA(0, 1), a2 + hstep, voffA);
            PG8_WAIT_V(8); PG8_WAIT_L(0); PG8_BAR; PG8_MMA(0, 0, At, B0); PG8_MMA(0, 1, At, B1); PG8_BAR; PG8_SCHED;
            PG8_LDA(At, 1, 1); PG8_STAGE(PG8_SB(1, 0), b3, voffB); PG8_STAGE(PG8_SB(1, 1), b3 + hstep, voffB); PG8_STAGE(PG8_SA(1, 0), a3, voffA);
            PG8_WAIT_V(8); PG8_WAIT_L(0); PG8_BAR; PG8_MMA(1, 0, At, B0); PG8_MMA(1, 1, At, B1); PG8_BAR; PG8_SCHED;
            } else {
            PG8_LDB(B0, 0, 0); PG8_SCHED; PG8_LDA(At, 0, 0); PG8_STAGE(PG8_SA(1, 1), a1 + hstep, voffA);
            PG8_WAIT_L(8); PG8_BAR; PG8_WAIT_L(0); PG8_MMA(0, 0, At, B0); PG8_BAR; PG8_SCHED;
            PG8_LDB(B1, 0, 1); PG8_STAGE(PG8_SB(0, 0), b2, voffB);
            PG8_BAR; PG8_WAIT_L(0); PG8_MMA(0, 1, At, B1); PG8_BAR;
            PG8_LDA(At, 0, 1); PG8_STAGE(PG8_SA(0, 0), a2, voffA);
            PG8_BAR; PG8_WAIT_L(0); PG8_MMA(1, 0, At, B0); PG8_BAR; PG8_SCHED;
            PG8_STAGE(PG8_SB(0, 1), b2 + hstep, voffB);
            PG8_WAIT_V(6); PG8_BAR; PG8_MMA(1, 1, At, B1); PG8_BAR;
            PG8_LDB(B0, 1, 0); PG8_SCHED; PG8_LDA(At, 1, 0); PG8_STAGE(PG8_SA(0, 1), a2 + hstep, voffA);
            PG8_WAIT_L(8); PG8_BAR; PG8_WAIT_L(0); PG8_MMA(0, 0, At, B0); PG8_BAR; PG8_SCHED;
            PG8_LDB(B1, 1, 1); PG8_STAGE(PG8_SB(1, 0), b3, voffB);
            PG8_BAR; PG8_WAIT_L(0); PG8_MMA(0, 1, At, B1); PG8_BAR;
            PG8_LDA(At, 1, 1); PG8_STAGE(PG8_SA(1, 0), a3, voffA);
            PG8_BAR; PG8_WAIT_L(0); PG8_MMA(1, 0, At, B0); PG8_BAR; PG8_SCHED;
            PG8_STAGE(PG8_SB(1, 1), b3 + hstep, voffB);
            PG8_WAIT_V(6); PG8_BAR; PG8_MMA(1, 1, At, B1); PG8_BAR;
            }
        }
        if constexpr (ALIGN_EPI) { if (wr == 0) PG8_BAR; }
        if constexpr (!Epi::AFTER_DRAIN) { E(acc, cur, wr, wc, fr, fq); S.done(cur); }
        if (!has_next) break;
#pragma unroll
        for (int a = 0; a < 2; ++a)
#pragma unroll
            for (int b = 0; b < 2; ++b)
#pragma unroll
                for (int m = 0; m < 4; ++m)
#pragma unroll
                    for (int n = 0; n < 2; ++n) acc[a][b][m][n] = (f32x4){0.f, 0.f, 0.f, 0.f};
        cur = nxt; cA = nA; cB = nB; ++ui;
        if constexpr (ALIGN_EPI) { if (wr == 1) PG8_BAR; }
    }
    PG8_WAIT_V(0);
    if constexpr (!ALIGN_EPI) { if (wr == 0) PG8_BAR; }
    PG8_BAR;
    if constexpr (Epi::AFTER_DRAIN) { E.fused(acc, cur, wr, wc, fr, fq, lds, wid, lane); S.done(cur); }
#undef PG8_SA
#undef PG8_SB
#undef PG8_STAGE
#undef PG8_LDA
#undef PG8_LDB
#undef PG8_MMA
#undef PG8_WAIT_V
#undef PG8_WAIT_L
#undef PG8_BAR
#undef PG8_SCHED
}
}
__device__ const float INVF_R[128] = {1.000000000e+00f, 9.300450087e-01f, 8.649836779e-01f, 8.044736385e-01f, 7.481966019e-01f, 6.958565116e-01f, 6.471778154e-01f, 6.019044518e-01f, 5.597981811e-01f, 5.206375122e-01f, 4.842162728e-01f, 4.503428936e-01f, 4.188391268e-01f, 3.895392120e-01f, 3.622889817e-01f, 3.369450271e-01f, 3.133740425e-01f, 2.914519310e-01f, 2.710633874e-01f, 2.521011233e-01f, 2.344653904e-01f, 2.180633694e-01f, 2.028087080e-01f, 1.886212230e-01f, 1.754262149e-01f, 1.631542742e-01f, 1.517407894e-01f, 1.411257535e-01f, 1.312533021e-01f, 1.220714748e-01f, 1.135319397e-01f, 1.055898219e-01f, 9.820328653e-02f, 9.133346379e-02f, 8.494423330e-02f, 7.900195569e-02f, 7.347535342e-02f, 6.833537668e-02f, 6.355497986e-02f, 5.910899118e-02f, 5.497401953e-02f, 5.112830922e-02f, 4.755162448e-02f, 4.422515258e-02f, 4.113136977e-02f, 3.825402260e-02f, 3.557796404e-02f, 3.308910504e-02f, 3.077435680e-02f, 2.862153389e-02f, 2.661931701e-02f, 2.475716174e-02f, 2.302526683e-02f, 2.141453326e-02f, 1.991648041e-02f, 1.852322184e-02f, 1.722742990e-02f, 1.602228358e-02f, 1.490144618e-02f, 1.385901403e-02f, 1.288950257e-02f, 1.198781747e-02f, 1.114920899e-02f, 1.036926545e-02f, 9.643883444e-03f, 8.969245479e-03f, 8.341802284e-03f, 7.758250926e-03f, 7.215522230e-03f, 6.710760761e-03f, 6.241309457e-03f, 5.804697983e-03f, 5.398627371e-03f, 5.020966288e-03f, 4.669724498e-03f, 4.343053792e-03f, 4.039235413e-03f, 3.756670747e-03f, 3.493872471e-03f, 3.249458736e-03f, 3.022142686e-03f, 2.810728736e-03f, 2.614103956e-03f, 2.431234345e-03f, 2.261157380e-03f, 2.102978062e-03f, 1.955864020e-03f, 1.819041790e-03f, 1.691789716e-03f, 1.573440502e-03f, 1.463370281e-03f, 1.361000235e-03f, 1.265791478e-03f, 1.177242957e-03f, 1.094888896e-03f, 1.018295996e-03f, 9.470609948e-04f, 8.808093844e-04f, 8.191923262e-04f, 7.618857198e-04f, 7.085879333e-04f, 6.590186385e-04f, 6.129170069e-04f, 5.700403708e-04f, 5.301629426e-04f, 4.930753494e-04f, 4.585822753e-04f, 4.265021416e-04f, 3.966661752e-04f, 3.689173318e-04f, 3.431097430e-04f, 3.191074939e-04f, 2.967843320e-04f, 2.760227653e-04f, 2.567135962e-04f, 2.387551940e-04f, 2.220530587e-04f, 2.065193403e-04f, 1.920722716e-04f, 1.786358480e-04f, 1.661392889e-04f, 1.545170089e-04f, 1.437077590e-04f, 1.336546848e-04f, 1.243048755e-04f, 1.156091312e-04f, 1.075216787e-04f, 9.999999747e-05f};
__device__ const float INVF_A[8] = {1.000000000e+00f, 1.939227581e-01f, 3.760603070e-02f, 7.292665076e-03f, 1.414213446e-03f, 2.742481884e-04f, 5.318296462e-05f, 1.031338525e-05f};
#define LAS __attribute__((address_space(3)))
typedef unsigned short bf16_t;
typedef short bf16x8 __attribute__((ext_vector_type(8)));
typedef short s16x4 __attribute__((ext_vector_type(4)));
typedef float f32x4 __attribute__((ext_vector_type(4)));
typedef unsigned u32x4 __attribute__((ext_vector_type(4)));
typedef unsigned u32x2 __attribute__((ext_vector_type(2)));

constexpr int NB = 2, SEQ = 4096, DM = 2048, MTOK = NB * SEQ, NIN = 12800, DFF = 5632, NGU = 2 * DFF;
constexpr int C_RQ = 0, C_RK = 1024, C_RV = 2048, C_RG = 4096, C_AQ = 6144, C_AK = 8192, C_AV = 8448, C_GA = 8704, C_GB = 10752;
constexpr float ALPHA = 1.189207115002721f, LN_EPS = 1e-5f, GN_EPS = 1e-5f;
constexpr int NWAVES = 8, NTHR = 512;
constexpr int LDS_BYTES = 147456;
constexpr size_t MiB = 1u << 20;
constexpr size_t WS_WOUT = 1 * MiB, WS_WGU = 9 * MiB, WS_WDN = 53 * MiB, WS_TABR = 75 * MiB, WS_TABA = 83 * MiB;
constexpr size_t WS_WIN = 84 * MiB, WS_XB = 134 * MiB;
constexpr size_t WS_ATT = 84 * MiB, WS_PREVT = 116 * MiB;
constexpr size_t WS_PROJ = 166 * MiB;
constexpr size_t WS_MERGED = 366 * MiB, WS_END = 398 * MiB;
constexpr size_t WS_H1 = 84 * MiB, WS_H1B = 148 * MiB, WS_ACT = 180 * MiB;
static_assert(WS_WGU + (size_t)NGU * DM * 2 <= WS_WDN && WS_WDN + (size_t)DM * DFF * 2 <= WS_TABR && WS_TABR + (size_t)MTOK * 256 * 4 <= WS_TABA && WS_TABA + (size_t)MTOK * 16 * 4 <= WS_WIN, "ws map 1");
static_assert(WS_WIN + (size_t)NIN * DM * 2 <= WS_XB && WS_XB + (size_t)MTOK * DM * 2 <= WS_PROJ && WS_PROJ + (size_t)MTOK * NIN * 2 <= WS_MERGED, "ws map 2");
static_assert(WS_PREVT + (size_t)NB * 4 * 16 * 512 * 256 * 2 <= WS_PROJ && WS_ACT + (size_t)MTOK * DFF * 2 <= WS_MERGED, "ws map 3");

__device__ const float LG2G[4] = {-4.580368961312e-02f, -2.272007650008e-02f, -1.131531322783e-02f, -5.646563141142e-03f};

__device__ __forceinline__ unsigned f2bf(float f) { unsigned u = __builtin_bit_cast(unsigned, f); return (u + 0x7fffu + ((u >> 16) & 1u)) >> 16; }
__device__ __forceinline__ unsigned pk2(float lo, float hi) { return f2bf(lo) | (f2bf(hi) << 16); }
__device__ __forceinline__ float bflo(unsigned w) { return __builtin_bit_cast(float, w << 16); }
__device__ __forceinline__ float bfhi(unsigned w) { return __builtin_bit_cast(float, w & 0xffff0000u); }
typedef float f32x2_t __attribute__((ext_vector_type(2))); typedef __bf16 bf16x2_t __attribute__((ext_vector_type(2)));
__device__ __forceinline__ unsigned cvtpk(float lo, float hi) { f32x2_t v = {lo, hi}; bf16x2_t b = __builtin_convertvector(v, bf16x2_t); return __builtin_bit_cast(unsigned, b); }
__device__ __forceinline__ f32x4 mfma16(bf16x8 a, bf16x8 b, f32x4 c) { return __builtin_amdgcn_mfma_f32_16x16x32_bf16(a, b, c, 0, 0, 0); }
typedef short v4i16_t __attribute__((ext_vector_type(4)));
__device__ __forceinline__ s16x4 tr_rd(LAS const unsigned char* p) { return __builtin_bit_cast(s16x4, __builtin_amdgcn_ds_read_tr16_b64_v4i16((LAS v4i16_t*)p)); }
__device__ __forceinline__ bf16x8 cat8(s16x4 a, s16x4 b) { return (bf16x8){a[0], a[1], a[2], a[3], b[0], b[1], b[2], b[3]}; }
__device__ __forceinline__ bf16x8 pack8(f32x4 a, f32x4 b) { u32x4 w; w.x = cvtpk(a[0], a[1]); w.y = cvtpk(a[2], a[3]); w.z = cvtpk(b[0], b[1]); w.w = cvtpk(b[2], b[3]); return __builtin_bit_cast(bf16x8, w); }
__device__ __forceinline__ float wave_sum(float v) {
#pragma unroll
    for (int o = 1; o < 64; o <<= 1) v += __shfl_xor(v, o);
    return v;
}

template <int MODE> __device__ __forceinline__ int dst_row(int c) {
    if (MODE == 1) {
        if (c < 2048) { const int j = c & 255; return (c & ~255) + ((j < 128) ? 2 * j : 2 * (j - 128) + 1); }
        if (c >= C_AQ && c < C_AV) { const int j = c & 63; if (j < 16) return (c & ~63) + ((j < 8) ? 2 * j : 2 * (j - 8) + 1); }
        return c;
    }
    if (MODE == 2) return ((c >> 7) << 8) + (c & 127);
    if (MODE == 3) return ((c >> 7) << 8) + 128 + (c & 127);
    return c;
}
template <int MODE> __device__ __forceinline__ void p0_transpose_item(const float* W, int K, int N, bf16_t* WT, LAS float* scr, int item, int lane) {
    const int nblk = N / 32, kb = item / nblk, nb = item % nblk, k0 = 64 * kb, n0 = 32 * nb;
#pragma unroll 8
    for (int i = 0; i < 32; ++i) { const int kk = 2 * i + (lane >> 5); scr[kk * 33 + (lane & 31)] = W[(size_t)(k0 + kk) * N + n0 + (lane & 31)]; }
    asm volatile("s_waitcnt lgkmcnt(0)" ::: "memory");
    const int c = lane & 7;
#pragma unroll
    for (int j = 0; j < 4; ++j) { const int n = (lane >> 3) + 8 * j; const LAS float* s = scr + (8 * c) * 33 + n;
        u32x4 o; o.x = pk2(s[0 * 33], s[1 * 33]); o.y = pk2(s[2 * 33], s[3 * 33]); o.z = pk2(s[4 * 33], s[5 * 33]); o.w = pk2(s[6 * 33], s[7 * 33]);
        *(u32x4*)(WT + (size_t)dst_row<MODE>(n0 + n) * K + k0 + 8 * c) = o; }
    asm volatile("s_waitcnt lgkmcnt(0)" ::: "memory");
}

struct Args { const float* in[14]; float* out; unsigned char* ws; int ph_lo, ph_hi; };

__device__ __forceinline__ void p0_prologue(const Args& a, LAS unsigned char* lds, int gw, int NGW, int wave, int lane) {
    LAS float* scr = (LAS float*)(lds + wave * 16384);
    unsigned char* ws = a.ws;
    const float* w_in = a.in[2]; const float* w_out = a.in[6]; const float* w_gate = a.in[9]; const float* w_up = a.in[10]; const float* w_down = a.in[11];
    constexpr int I_IN = (DM / 64) * (NIN / 32), I_OUT = (DM / 64) * (DM / 32), I_G = (DM / 64) * (DFF / 32), I_D = (DFF / 64) * (DM / 32);
    constexpr int NITEMS = I_IN + I_OUT + 2 * I_G + I_D;
    for (int it = gw; it < NITEMS; it += NGW) {
        int r = it;
        if (r < I_IN) { p0_transpose_item<1>(w_in, DM, NIN, (bf16_t*)(ws + WS_WIN), scr, r, lane); continue; } r -= I_IN;
        if (r < I_OUT) { p0_transpose_item<0>(w_out, DM, DM, (bf16_t*)(ws + WS_WOUT), scr, r, lane); continue; } r -= I_OUT;
        if (r < I_G) { p0_transpose_item<2>(w_gate, DM, DFF, (bf16_t*)(ws + WS_WGU), scr, r, lane); continue; } r -= I_G;
        if (r < I_G) { p0_transpose_item<3>(w_up, DM, DFF, (bf16_t*)(ws + WS_WGU), scr, r, lane); continue; } r -= I_G;
        p0_transpose_item<0>(w_down, DFF, DM, (bf16_t*)(ws + WS_WDN), scr, r, lane);
    }
    const float* x = a.in[0]; bf16_t* xb = (bf16_t*)(ws + WS_XB);
    for (int m = gw; m < MTOK; m += NGW) {
        const f32x4* xr = (const f32x4*)(x + (size_t)m * DM) + lane; u32x2* o = (u32x2*)(xb + (size_t)m * DM) + lane;
#pragma unroll
        for (int j = 0; j < 8; ++j) { const f32x4 v = xr[64 * j]; u32x2 w; w.x = pk2(v[0], v[1]); w.y = pk2(v[2], v[3]); o[64 * j] = w; }
    }
    const int* pos = (const int*)a.in[1]; float* tabR = (float*)(ws + WS_TABR); float* tabA = (float*)(ws + WS_TABA);
    const int gt = gw * 64 + lane, NGT = NGW * 64;
    for (int i = gt; i < MTOK * 136; i += NGT) {
        const int row = i / 136, j = i % 136; const double p = (double)pos[row];
        const double fr = (j < 128) ? (double)INVF_R[j] : (double)INVF_A[j - 128];
        double t = p * fr * 0.15915494309189535; t -= __builtin_rint(t);
        const float tf = (float)t; const float cs = __builtin_amdgcn_cosf(tf), sn = __builtin_amdgcn_sinf(tf);
        if (j < 128) { tabR[(size_t)row * 256 + j] = cs; tabR[(size_t)row * 256 + 128 + j] = sn; }
        else { tabA[(size_t)row * 16 + (j - 128)] = cs; tabA[(size_t)row * 16 + 8 + (j - 128)] = sn; }
    }
}

constexpr int SC_KP = 544, SC_VP = 160, SC_VOFF = 128 * SC_KP;
__device__ __forceinline__ void scan_item(LAS unsigned char* lds, const bf16_t* proj, bf16_t* prevT, int item) {
    const int tid = threadIdx.x, lane = tid & 63, w = __builtin_amdgcn_readfirstlane(tid >> 6), fr = lane & 15, fq = lane >> 4, q4 = (lane & 15) >> 2, p4 = lane & 3;
    const int es = item & 7, h = (item >> 3) & 3, b = item >> 5;
    const float lg = LG2G[h];
    f32x4 acc[2][4];
#pragma unroll
    for (int i = 0; i < 2; ++i)
#pragma unroll
        for (int j = 0; j < 4; ++j) acc[i][j] = (f32x4){0.f, 0.f, 0.f, 0.f};
    const bf16_t* kbase = proj + (size_t)(b * SEQ) * NIN + C_RK + 256 * h;
    const bf16_t* vbase = proj + (size_t)(b * SEQ) * NIN + C_RV + 512 * h + 64 * es;
    u32x4 kr[8], vr[2];
#define SC_LOAD(step) do { const int row0_ = (step) * 128; \
    _Pragma("unroll") for (int j = 0; j < 8; ++j) { const int p = tid + 512 * j; kr[j] = *(const u32x4*)(kbase + (size_t)(row0_ + (p >> 5)) * NIN + (p & 31) * 8); } \
    _Pragma("unroll") for (int j = 0; j < 2; ++j) { const int p = tid + 512 * j; vr[j] = *(const u32x4*)(vbase + (size_t)(row0_ + (p >> 3)) * NIN + (p & 7) * 8); } } while (0)
    SC_LOAD(0);
    for (int step = 0; step < 30; ++step) {
        __syncthreads();
#pragma unroll
        for (int j = 0; j < 8; ++j) { const int p = tid + 512 * j; *(LAS u32x4*)(lds + (p >> 5) * SC_KP + (p & 31) * 16) = kr[j]; }
#pragma unroll
        for (int j = 0; j < 2; ++j) { const int p = tid + 512 * j; const int r = p >> 3; const float dc = __builtin_amdgcn_exp2f(lg * (float)(255 - ((step & 1) * 128 + r)));
            u32x4 v = vr[j], o;
            o.x = cvtpk(bflo(v.x) * dc, bfhi(v.x) * dc); o.y = cvtpk(bflo(v.y) * dc, bfhi(v.y) * dc);
            o.z = cvtpk(bflo(v.z) * dc, bfhi(v.z) * dc); o.w = cvtpk(bflo(v.w) * dc, bfhi(v.w) * dc);
            *(LAS u32x4*)(lds + SC_VOFF + r * SC_VP + (p & 7) * 16) = o; }
        __syncthreads();
        if (step + 1 < 30) SC_LOAD(step + 1);
        if ((step & 1) == 0 && step > 0) { const float cd = __builtin_amdgcn_exp2f(lg * 256.0f);
#pragma unroll
            for (int i = 0; i < 2; ++i)
#pragma unroll
                for (int j = 0; j < 4; ++j) acc[i][j] = acc[i][j] * cd; }
#pragma unroll
        for (int ks = 0; ks < 4; ++ks) {
            const int rbase = 32 * ks + 8 * fq + q4;
            bf16x8 af[2], bfr[4];
#pragma unroll
            for (int dt = 0; dt < 2; ++dt) { const LAS unsigned char* p = lds + rbase * SC_KP + (32 * w + 16 * dt + 4 * p4) * 2; af[dt] = cat8(tr_rd(p), tr_rd(p + 4 * SC_KP)); }
#pragma unroll
            for (int et = 0; et < 4; ++et) { const LAS unsigned char* p = lds + SC_VOFF + rbase * SC_VP + (16 * et + 4 * p4) * 2; bfr[et] = cat8(tr_rd(p), tr_rd(p + 4 * SC_VP)); }
#pragma unroll
            for (int dt = 0; dt < 2; ++dt)
#pragma unroll
                for (int et = 0; et < 4; ++et) acc[dt][et] = mfma16(af[dt], bfr[et], acc[dt][et]);
        }
        if (step & 1) { const int n1 = (step >> 1) + 1;
            bf16_t* ob = prevT + ((size_t)((b * 4 + h) * 16 + n1) * 512 + 64 * es) * 256;
#pragma unroll
            for (int dt = 0; dt < 2; ++dt)
#pragma unroll
                for (int et = 0; et < 4; ++et) { u32x2 o; o.x = cvtpk(acc[dt][et][0], acc[dt][et][1]); o.y = cvtpk(acc[dt][et][2], acc[dt][et][3]);
                    *(u32x2*)(ob + (size_t)(16 * et + fr) * 256 + 32 * w + 16 * dt + 4 * fq) = o; } }
    }
#undef SC_LOAD
    __syncthreads();
}

constexpr int AT_KP = 144, AT_VP = 160, AT_VOFF = 256 * AT_KP;
__device__ __forceinline__ void attn_item(LAS unsigned char* lds, const bf16_t* proj, const float* sinks, bf16_t* att, int item) {
    const int tid = threadIdx.x, lane = tid & 63, w = __builtin_amdgcn_readfirstlane(tid >> 6), fr = lane & 15, fq = lane >> 4, q4 = (lane & 15) >> 2, p4 = lane & 3;
    const int n = item & 31, kvh = (item >> 5) & 3, b = item >> 7;
    __syncthreads();
    {
        const long tok0 = (long)b * SEQ + 128 * (n - 1);
#pragma unroll
        for (int j = 0; j < 4; ++j) { const int p = tid + 512 * j, r = p >> 3, ch = p & 7;
            u32x4 kv = (u32x4){0u, 0u, 0u, 0u}, vv = (u32x4){0u, 0u, 0u, 0u};
            if (n > 0 || r >= 128) { const bf16_t* src = proj + (size_t)(tok0 + r) * NIN; kv = *(const u32x4*)(src + C_AK + 64 * kvh + ch * 8); vv = *(const u32x4*)(src + C_AV + 64 * kvh + ch * 8); }
            *(LAS u32x4*)(lds + r * AT_KP + ch * 16) = kv; *(LAS u32x4*)(lds + AT_VOFF + r * AT_VP + ch * 16) = vv; }
        if (tid < 160) *(LAS u32x4*)(lds + AT_VOFF + 256 * AT_VP + tid * 16) = (u32x4){0u, 0u, 0u, 0u};
    }
    __syncthreads();
    const int head = 8 * kvh + w;
    const float sink2 = sinks[head] * 1.4426950408889634f;
    for (int sb = 0; sb < 8; ++sb) {
        const size_t tok = (size_t)b * SEQ + 128 * n + 16 * sb + fr;
        bf16x8 qf[2];
#pragma unroll
        for (int s = 0; s < 2; ++s) qf[s] = *(const bf16x8*)(proj + tok * NIN + C_AQ + 64 * head + 32 * s + 8 * fq);
        f32x4 st[9];
#pragma unroll
        for (int t = 0; t < 9; ++t) { st[t] = (f32x4){0.f, 0.f, 0.f, 0.f};
#pragma unroll
            for (int s = 0; s < 2; ++s) { const bf16x8 kf = *(const LAS bf16x8*)(lds + (16 * (sb + t) + fr) * AT_KP + (32 * s + 8 * fq) * 2); st[t] = mfma16(kf, qf[s], st[t]); } }
        const int qi = 16 * sb + fr; float mx = -INFINITY;
#pragma unroll
        for (int t = 0; t < 9; ++t)
#pragma unroll
            for (int i = 0; i < 4; ++i) { const int kj = 16 * (sb + t) + 4 * fq + i, dist = 128 + qi - kj; const bool ok = (dist >= 0) && (dist < 128) && (n > 0 || kj >= 128);
                const float v = ok ? st[t][i] : -INFINITY; st[t][i] = v; mx = fmaxf(mx, v); }
        mx = fmaxf(mx, __shfl_xor(mx, 16)); mx = fmaxf(mx, __shfl_xor(mx, 32)); mx = fmaxf(mx, sink2);
        float sum = 0.f;
#pragma unroll
        for (int t = 0; t < 9; ++t)
#pragma unroll
            for (int i = 0; i < 4; ++i) { const float p = __builtin_amdgcn_exp2f(st[t][i] - mx); st[t][i] = p; sum += p; }
        sum += __shfl_xor(sum, 16); sum += __shfl_xor(sum, 32);
        const float rden = 1.0f / (sum + __builtin_amdgcn_exp2f(sink2 - mx));
        f32x4 o[4];
#pragma unroll
        for (int dt = 0; dt < 4; ++dt) o[dt] = (f32x4){0.f, 0.f, 0.f, 0.f};
#pragma unroll
        for (int ks = 0; ks < 5; ++ks) {
            const bf16x8 pf = pack8(st[2 * ks], (2 * ks + 1 < 9) ? st[(2 * ks + 1 < 9) ? 2 * ks + 1 : 8] : (f32x4){0.f, 0.f, 0.f, 0.f});
            const LAS unsigned char* vb = lds + AT_VOFF + (16 * (sb + 2 * ks) + 4 * fq + q4) * AT_VP + (4 * p4) * 2;
#pragma unroll
            for (int dt = 0; dt < 4; ++dt) { const bf16x8 vf = cat8(tr_rd(vb + dt * 32), tr_rd(vb + 16 * AT_VP + dt * 32)); o[dt] = mfma16(vf, pf, o[dt]); }
        }
        bf16_t* op = att + tok * DM + 64 * head + 4 * fq;
#pragma unroll
        for (int dt = 0; dt < 4; ++dt) { u32x2 ov; ov.x = cvtpk(o[dt][0] * rden, o[dt][1] * rden); ov.y = cvtpk(o[dt][2] * rden, o[dt][3] * rden); *(u32x2*)(op + 16 * dt) = ov; }
    }
}

constexpr int R3_P = 528, R3_VP = 1056, R3_VOFF = 32 * R3_P, R3_BUF = R3_VOFF + 32 * R3_VP;
static_assert(R3_BUF >= 64 * R3_P && 2 * R3_BUF <= 131072, "P3 LDS");
__device__ __forceinline__ void ret_item(LAS unsigned char* lds, const bf16_t* proj, const bf16_t* prevT, const bf16_t* att, const float* gn_g, const float* gn_b, bf16_t* merged, int item) {
    const int tid = threadIdx.x, lane = tid & 63, w = __builtin_amdgcn_readfirstlane(tid >> 6), fr = lane & 15, fq = lane >> 4, q4 = (lane & 15) >> 2, p4 = lane & 3;
    const int half = item & 1, n = (item >> 1) & 15, h = (item >> 5) & 3, b = item >> 7;
    const float lg = LG2G[h];
    const int c0 = 128 * half + 16 * w;
    const size_t tokc = (size_t)b * SEQ + 256 * n;
    bf16x8 qf[8];
#pragma unroll
    for (int s = 0; s < 8; ++s) qf[s] = *(const bf16x8*)(proj + (tokc + c0) * NIN + C_RQ + 256 * h + (unsigned)(fr * NIN + 32 * s + 8 * fq));
    f32x4 acc[32];
#pragma unroll
    for (int i = 0; i < 32; ++i) acc[i] = (f32x4){0.f, 0.f, 0.f, 0.f};
    u32x4 pr[6];
    const bf16_t* pT = prevT + (size_t)((b * 4 + h) * 16 + n) * 512 * 256;
    const bf16_t* kg = proj + tokc * NIN + C_RK + 256 * h;
    const bf16_t* vg = proj + tokc * NIN + C_RV + 512 * h;
#define R3_LOAD1(eb) do { int tq_ = tid; asm volatile("" : "+v"(tq_)); const bf16_t* b_ = pT + (size_t)(64 * (eb)) * 256; _Pragma("unroll") for (int j = 0; j < 4; ++j) { const int p = tq_ + 512 * j; pr[j] = *(const u32x4*)(b_ + (unsigned)((p >> 5) * 256 + (p & 31) * 8)); } } while (0)
#define R3_STORE1(buf) do { int tq_ = tid; asm volatile("" : "+v"(tq_)); _Pragma("unroll") for (int j = 0; j < 4; ++j) { const int p = tq_ + 512 * j; *(LAS u32x4*)((buf) + (p >> 5) * R3_P + (p & 31) * 16) = pr[j]; } } while (0)
#define R3_LOAD2(kb) do { int tq_ = tid; asm volatile("" : "+v"(tq_)); const bf16_t* kb_ = kg + (size_t)(32 * (kb)) * NIN; const bf16_t* vb_ = vg + (size_t)(32 * (kb)) * NIN; _Pragma("unroll") for (int j = 0; j < 2; ++j) { const int p = tq_ + 512 * j; pr[j] = *(const u32x4*)(kb_ + (unsigned)((p >> 5) * NIN + (p & 31) * 8)); } \
    _Pragma("unroll") for (int j = 0; j < 4; ++j) { const int p = tq_ + 512 * j; pr[2 + j] = *(const u32x4*)(vb_ + (unsigned)((p >> 6) * NIN + (p & 63) * 8)); } } while (0)
#define R3_STORE2(buf) do { int tq_ = tid; asm volatile("" : "+v"(tq_)); _Pragma("unroll") for (int j = 0; j < 2; ++j) { const int p = tq_ + 512 * j; *(LAS u32x4*)((buf) + (p >> 5) * R3_P + (p & 31) * 16) = pr[j]; } \
    _Pragma("unroll") for (int j = 0; j < 4; ++j) { const int p = tq_ + 512 * j; *(LAS u32x4*)((buf) + R3_VOFF + (p >> 6) * R3_VP + (p & 63) * 16) = pr[2 + j]; } } while (0)
    __syncthreads();
    if (n > 0) { R3_LOAD1(0); R3_STORE1(lds); } else { R3_LOAD2(0); R3_STORE2(lds); }
    __syncthreads();
    if (n > 0) {
#pragma unroll
        for (int eb = 0; eb < 8; ++eb) {
            LAS unsigned char* cur = lds + (eb & 1) * R3_BUF; LAS unsigned char* nxt = lds + ((eb + 1) & 1) * R3_BUF;
            if (eb < 7) R3_LOAD1(eb + 1); else R3_LOAD2(0);
#pragma unroll
            for (int et = 0; et < 4; ++et)
#pragma unroll
                for (int s = 0; s < 8; ++s) { const bf16x8 af = *(const LAS bf16x8*)(cur + (16 * et + fr) * R3_P + (32 * s + 8 * fq) * 2); acc[4 * eb + et] = mfma16(af, qf[s], acc[4 * eb + et]); if (s == 7) __builtin_amdgcn_sched_barrier(0); }
            if (eb < 7) R3_STORE1(nxt); else R3_STORE2(nxt);
            __syncthreads();
        }
        const float qd = __builtin_amdgcn_exp2f(lg * (float)(c0 + fr + 1));
#pragma unroll
        for (int i = 0; i < 32; ++i) acc[i] = acc[i] * qd;
    }
    const int nkb = 4 * (half + 1);
    for (int kb = 0; kb < nkb; ++kb) {
        LAS unsigned char* cur = lds + (kb & 1) * R3_BUF; LAS unsigned char* nxt = lds + ((kb + 1) & 1) * R3_BUF;
        if (kb + 1 < nkb) R3_LOAD2(kb + 1);
        if (32 * kb <= c0 + 15) {
            f32x4 st[2];
#pragma unroll
            for (int t = 0; t < 2; ++t) { st[t] = (f32x4){0.f, 0.f, 0.f, 0.f};
#pragma unroll
                for (int s = 0; s < 8; ++s) { const bf16x8 kf = *(const LAS bf16x8*)(cur + (16 * t + fr) * R3_P + (32 * s + 8 * fq) * 2); st[t] = mfma16(kf, qf[s], st[t]); } }
            const int c = c0 + fr;
#pragma unroll
            for (int t = 0; t < 2; ++t)
#pragma unroll
                for (int i = 0; i < 4; ++i) { const int dlt = c - (32 * kb + 16 * t + 4 * fq + i); st[t][i] = (dlt >= 0) ? st[t][i] * __builtin_amdgcn_exp2f(lg * (float)dlt) : 0.f; }
            const bf16x8 pf = pack8(st[0], st[1]);
            const LAS unsigned char* vb = cur + R3_VOFF + (4 * fq + q4) * R3_VP + (4 * p4) * 2;
#pragma unroll
            for (int et = 0; et < 32; ++et) { const bf16x8 vf = cat8(tr_rd(vb + et * 32), tr_rd(vb + 16 * R3_VP + et * 32)); acc[et] = mfma16(vf, pf, acc[et]); if ((et & 3) == 3) __builtin_amdgcn_sched_barrier(0); }
        }
        if (kb + 1 < nkb) R3_STORE2(nxt);
        __syncthreads();
    }
#undef R3_LOAD1
#undef R3_STORE1
#undef R3_LOAD2
#undef R3_STORE2
    float s1 = 0.f;
#pragma unroll
    for (int i = 0; i < 32; ++i) s1 += (acc[i][0] + acc[i][1]) + (acc[i][2] + acc[i][3]);
    s1 += __shfl_xor(s1, 16); s1 += __shfl_xor(s1, 32);
    const float mu = s1 * (1.0f / 512.0f); float s2 = 0.f;
#pragma unroll
    for (int i = 0; i < 32; ++i) { const f32x4 d = acc[i] - mu; s2 += (d[0] * d[0] + d[1] * d[1]) + (d[2] * d[2] + d[3] * d[3]); }
    s2 += __shfl_xor(s2, 16); s2 += __shfl_xor(s2, 32);
    const float rstd = 1.0f / sqrtf(s2 * (1.0f / 512.0f) + GN_EPS);
    const bf16_t* prow0 = proj + (tokc + c0) * NIN; const bf16_t* arow0 = att + (tokc + c0) * DM; bf16_t* mrow0 = merged + (tokc + c0) * DM;
#pragma unroll
    for (int et = 0; et < 32; ++et) { const int col = 512 * h + 16 * et + 4 * fq;
        const f32x4 gg = *(const f32x4*)(gn_g + col), gb = *(const f32x4*)(gn_b + col);
        const unsigned po = (unsigned)(fr * NIN + col), ao = (unsigned)(fr * DM + col);
        const u32x2 sg = *(const u32x2*)(prow0 + C_RG + po), ga = *(const u32x2*)(prow0 + C_GA + po), gbb = *(const u32x2*)(prow0 + C_GB + po), av = *(const u32x2*)(arow0 + ao);
        const f32x4 y = (acc[et] - mu) * rstd * gg + gb;
        const float r0 = bflo(ga.x) * (bflo(sg.x) * y[0]) + bflo(gbb.x) * bflo(av.x), r1 = bfhi(ga.x) * (bfhi(sg.x) * y[1]) + bfhi(gbb.x) * bfhi(av.x);
        const float r2 = bflo(ga.y) * (bflo(sg.y) * y[2]) + bflo(gbb.y) * bflo(av.y), r3 = bfhi(ga.y) * (bfhi(sg.y) * y[3]) + bfhi(gbb.y) * bfhi(av.y);
        u32x2 o; o.x = cvtpk(r0, r1); o.y = cvtpk(r2, r3); *(u32x2*)(mrow0 + ao) = o; if (et & 1) __builtin_amdgcn_sched_barrier(0); }
}

template <bool WB> __device__ __forceinline__ void ln_rows(const float* z, const float* g, const float* bta, float* outf, bf16_t* outb, int gw, int NGW, int lane) {
    for (int m = gw; m < MTOK; m += NGW) {
        const f32x4* zr = (const f32x4*)(z + (size_t)m * DM) + lane; f32x4 v[8]; float s = 0.f;
#pragma unroll
        for (int j = 0; j < 8; ++j) { v[j] = zr[64 * j]; s += (v[j][0] + v[j][1]) + (v[j][2] + v[j][3]); }
        const float mean = wave_sum(s) * (1.0f / DM); float s2 = 0.f;
#pragma unroll
        for (int j = 0; j < 8; ++j) { v[j] = v[j] - mean; s2 += (v[j][0] * v[j][0] + v[j][1] * v[j][1]) + (v[j][2] * v[j][2] + v[j][3] * v[j][3]); }
        const float rstd = 1.0f / sqrtf(wave_sum(s2) * (1.0f / DM) + LN_EPS);
        f32x4* of = (f32x4*)(outf + (size_t)m * DM) + lane; u32x2* ob = (u32x2*)(outb + (size_t)m * DM) + lane;
#pragma unroll
        for (int j = 0; j < 8; ++j) { const f32x4 gg = ((const f32x4*)g)[lane + 64 * j], bb = ((const f32x4*)bta)[lane + 64 * j]; const f32x4 y = v[j] * rstd * gg + bb; of[64 * j] = y;
            if (WB) { u32x2 w; w.x = pk2(y[0], y[1]); w.y = pk2(y[2], y[3]); ob[64 * j] = w; } }
    }
}

#ifndef MK_PER_PHASE
#define MK_PER_PHASE 0
#endif
constexpr int N_PHASES = 9;
__global__ void __launch_bounds__(NTHR, 2) hybrid_fwd(Args args) {
    extern __shared__ __attribute__((aligned(16))) unsigned char lds_raw[];
    LAS unsigned char* lds = (LAS unsigned char*)lds_raw;
    const int tid = threadIdx.x, lane = tid & 63, wave = __builtin_amdgcn_readfirstlane(tid >> 6);
    const int G = gridDim.x, bx = blockIdx.x;
    const int gw = bx * NWAVES + wave, NGW = G * NWAVES;
    unsigned char* ws = args.ws;
    bf16_t* proj = (bf16_t*)(ws + WS_PROJ); bf16_t* attb = (bf16_t*)(ws + WS_ATT); bf16_t* prevT = (bf16_t*)(ws + WS_PREVT); bf16_t* merged = (bf16_t*)(ws + WS_MERGED);
    float* zbuf = args.out; float* h1 = (float*)(ws + WS_H1); bf16_t* h1b = (bf16_t*)(ws + WS_H1B); bf16_t* actb = (bf16_t*)(ws + WS_ACT);
    const int lo = args.ph_lo, hi = args.ph_hi;
#ifndef PH_MASK
#define PH_MASK 0x1ff
#endif
#define IN(k) ((((PH_MASK) >> (k)) & 1) && lo <= (k) && (k) < hi)
#if MK_PER_PHASE
#define GRID_BAR() do { } while (0)
#else
#define GRID_BAR() do { __threadfence(); cg::this_grid().sync(); } while (0)
#endif
    if (IN(0)) { p0_prologue(args, lds, gw, NGW, wave, lane); if (IN(1)) GRID_BAR(); }
    if (IN(1)) {
        pg8::Gemm g{(const bf16_t*)(ws + WS_XB), (const bf16_t*)(ws + WS_WIN), MTOK, NIN, DM}; pg8::StaticOrder S; S.init(MTOK, NIN, G, bx);
        pg8::EpiInProj E{proj, (const float*)(ws + WS_TABR), (const float*)(ws + WS_TABA)};
        pg8::gemm_phase<pg8::EpiInProj, pg8::StaticOrder, true, true>(lds, g, S, E);
        if (IN(2)) GRID_BAR();
    }
    if (IN(2)) {
        for (int it = bx; it < 64 + 256; it += G) { if (it < 64) scan_item(lds, proj, prevT, it); else attn_item(lds, proj, args.in[5], attb, it - 64); }
        if (IN(3)) GRID_BAR();
    }
    if (IN(3)) {
        for (int it = bx; it < 256; it += G) ret_item(lds, proj, prevT, attb, args.in[3], args.in[4], merged, it);
        __syncthreads();
        if (IN(4)) GRID_BAR();
    }
    if (IN(4)) {
        pg8::Gemm g{merged, (const bf16_t*)(ws + WS_WOUT), MTOK, DM, DM}; pg8::StaticOrder S; S.init(MTOK, DM, G, bx);
        pg8::EpiResF32 E{args.in[0], zbuf, DM, ALPHA};
        pg8::gemm_phase<pg8::EpiResF32, pg8::StaticOrder, true, true>(lds, g, S, E);
        if (IN(5)) GRID_BAR();
    }
    if (IN(5)) { ln_rows<true>(zbuf, args.in[7], args.in[8], h1, h1b, gw, NGW, lane); if (IN(6)) GRID_BAR(); }
    if (IN(6)) {
        pg8::Gemm g{h1b, (const bf16_t*)(ws + WS_WGU), MTOK, NGU, DM}; pg8::StaticOrder S; S.init(MTOK, NGU, G, bx);
        pg8::EpiSwiGLU E{actb, DFF};
        pg8::gemm_phase<pg8::EpiSwiGLU, pg8::StaticOrder, true, true>(lds, g, S, E);
        if (IN(7)) GRID_BAR();
    }
    if (IN(7)) {
        pg8::Gemm g{actb, (const bf16_t*)(ws + WS_WDN), MTOK, DM, DFF}; pg8::StaticOrder S; S.init(MTOK, DM, G, bx);
        pg8::EpiResF32 E{h1, zbuf, DM, ALPHA};
        pg8::gemm_phase<pg8::EpiResF32, pg8::StaticOrder, true, true>(lds, g, S, E);
        if (IN(8)) GRID_BAR();
    }
    if (IN(8)) { ln_rows<false>(zbuf, args.in[12], args.in[13], args.out, nullptr, gw, NGW, lane); }
#undef IN
#undef GRID_BAR
}

#ifndef DBG_STOP
#define DBG_STOP 0
#endif
__global__ void dbg_dump(const unsigned short* src, int pitch, float* out) {
    const size_t i = (size_t)blockIdx.x * blockDim.x + threadIdx.x;
    const size_t r = i / DM, c = i % DM;
    float acc = 0.f;
    for (size_t cc = c; cc < (size_t)pitch; cc += DM) acc += __builtin_bit_cast(float, (unsigned)src[r * pitch + cc] << 16);
    out[i] = acc;
}
extern "C" void kernel_launch(void* const* d_in, const int* in_sizes, int n_in, void* d_out, int out_size, void* d_ws, size_t ws_size, hipStream_t stream) {
    static int grid = 0;
    if (grid == 0) {
        if (n_in != 14 || in_sizes[0] != MTOK * DM || out_size != MTOK * DM || ws_size < WS_END) { fprintf(stderr, "kernel_launch: unexpected shapes / workspace (n_in %d, ws %zu, need %zu)\n", n_in, ws_size, (size_t)WS_END); grid = -1; return; }
        int dev = 0, cus = 0, per_cu = 0;
        if (hipGetDevice(&dev) != hipSuccess || hipDeviceGetAttribute(&cus, hipDeviceAttributeMultiprocessorCount, dev) != hipSuccess) { grid = -1; return; }
        if (hipFuncSetAttribute((const void*)hybrid_fwd, hipFuncAttributeMaxDynamicSharedMemorySize, LDS_BYTES) != hipSuccess) { fprintf(stderr, "kernel_launch: hipFuncSetAttribute failed\n"); grid = -1; return; }
        if (hipOccupancyMaxActiveBlocksPerMultiprocessor(&per_cu, (const void*)hybrid_fwd, NTHR, LDS_BYTES) != hipSuccess || per_cu < 1) { fprintf(stderr, "kernel_launch: occupancy query gave %d\n", per_cu); per_cu = 1; }
        (void)hipGetLastError();
        grid = cus * per_cu;
    }
    if (grid < 0) return;
    Args a{};
    for (int i = 0; i < 14; ++i) a.in[i] = (const float*)d_in[i];
    a.out = (float*)d_out; a.ws = (unsigned char*)d_ws;
#if MK_PER_PHASE
    const int np_ = DBG_STOP ? DBG_STOP + 1 : N_PHASES;
    for (int p = 0; p < np_; ++p) { a.ph_lo = p; a.ph_hi = p + 1; hipLaunchKernelGGL(hybrid_fwd, dim3(grid), dim3(NTHR), LDS_BYTES, stream, a); }
    if (DBG_STOP == 1) hipLaunchKernelGGL(dbg_dump, dim3(MTOK * DM / 256), dim3(256), 0, stream, (const unsigned short*)((unsigned char*)d_ws + WS_PROJ), NIN, (float*)d_out);
    if (DBG_STOP == 2) hipLaunchKernelGGL(dbg_dump, dim3(MTOK * DM / 256), dim3(256), 0, stream, (const unsigned short*)((unsigned char*)d_ws + WS_PREVT), DM, (float*)d_out);
    if (DBG_STOP == 3) hipLaunchKernelGGL(dbg_dump, dim3(MTOK * DM / 256), dim3(256), 0, stream, (const unsigned short*)((unsigned char*)d_ws + WS_MERGED), DM, (float*)d_out);
    if (DBG_STOP == 6) hipLaunchKernelGGL(dbg_dump, dim3(MTOK * DM / 256), dim3(256), 0, stream, (const unsigned short*)((unsigned char*)d_ws + WS_ACT), DFF, (float*)d_out);
#else
    a.ph_lo = 0; a.ph_hi = N_PHASES;
    void* kargs[] = {&a};
    hipError_t e = hipLaunchCooperativeKernel((const void*)hybrid_fwd, dim3(grid), dim3(NTHR), kargs, LDS_BYTES, stream);
    if (e != hipSuccess) fprintf(stderr, "cooperative launch failed: %s (grid %d)\n", hipGetErrorString(e), grid);
#endif
}
```

```cpp
#include <hip/hip_runtime.h>
#include <hip/hip_cooperative_groups.h>
#include <cstdio>
#include <cstdint>
namespace cg = cooperative_groups;
namespace pg8 {
#define PG8_LAS __attribute__((address_space(3)))
typedef unsigned short bf16_t;
typedef short bf16x8 __attribute__((ext_vector_type(8)));
typedef float f32x4 __attribute__((ext_vector_type(4)));
typedef unsigned u32x4 __attribute__((ext_vector_type(4)));
constexpr int BM = 256, BK = 64, HALF = 128, HTB = HALF * BK * 2  , STAGE_BYTES = 8 * HTB, NXCD = 8, WGM = 8;

__host__ __device__ __forceinline__ int lds_byte(int r, int c) { const int st = (r >> 4) * 2 + (c >> 5), rr = r & 15, cc = c & 31, ob = rr * 64 + cc * 2; return st * 1024 + (ob ^ (((ob >> 9) & 1) << 5)); }
__host__ __device__ __forceinline__ void stage_rc(int b, int& R, int& C) { const int st = b / 1024, sb = b % 1024, swz = sb ^ (((sb >> 9) & 1) << 5); R = (st >> 1) * 16 + swz / 64; C = (st & 1) * 32 + (swz % 64) / 2; }
__host__ __device__ __forceinline__ int perm32(int rho) { const int n = rho >> 4, i = rho & 15; return 8 * (i >> 2) + 4 * n + (i & 3); }

struct Unit { int pm, pn; };
struct Gemm { const bf16_t* A; const bf16_t* Bt; int M, N, K; };

struct StaticOrder {
    int nM, nN, nwg, G, c;
    __host__ __device__ void init(int M, int N, int G_, int c_) { nM = M / BM; nN = N / BM; nwg = nM * nN; G = G_; c = c_; }
    __host__ __device__ bool next(int i, Unit& u) const {
        const long L = (long)i * G + c; if (L >= nwg) return false;
        int wgid = (int)L; { const int q = nwg / NXCD, r = nwg % NXCD, xcd = wgid % NXCD, off = wgid / NXCD; wgid = (xcd < r ? xcd * (q + 1) : r * (q + 1) + (xcd - r) * q) + off; }
        const int nig = WGM * nN, gid = wgid / nig, fm = gid * WGM, gsz = (nM - fm) < WGM ? (nM - fm) : WGM;
        u.pm = fm + ((wgid % nig) % gsz); u.pn = (wgid % nig) / gsz; return true;
    }
    __device__ __forceinline__ void a_ready(const Unit&) const {}
    __device__ __forceinline__ void done(const Unit&) const {}
};

__device__ __forceinline__ unsigned cvt_pk_bf16(float lo, float hi) { unsigned r; asm volatile("v_cvt_pk_bf16_f32 %0, %1, %2" : "=v"(r) : "v"(lo), "v"(hi)); return r; }
typedef float f32x2 __attribute__((ext_vector_type(2)));
__device__ __forceinline__ float sigmoidf_(float x) { return __builtin_amdgcn_rcpf(1.0f + __expf(-x)); }
struct EpiInProj {
    static constexpr bool PERM = true, AFTER_DRAIN = false;
    bf16_t* O; const float* tabR; const float* tabA;
    __device__ __forceinline__ void operator()(const f32x4 (&acc)[2][2][4][2], const Unit& u, int wr, int wc, int fr, int fq) const {
        const int pn = u.pn, ldc = 12800;
        const int row0 = u.pm * BM + wr * 64 + fr, col0 = pn * BM + wc * 32 + 8 * fq;
        int mode; float sc = 1.f;
        if (pn < 4) { mode = 1; sc = 0.0625f; } else if (pn < 8) { mode = 1; } else if (pn < 16) { mode = 0; } else if (pn < 24) { mode = 2; }
        else if (pn < 32) { mode = 3; sc = 0.18033688011112042f; } else if (pn == 32) { mode = 3; } else if (pn == 33) { mode = 0; } else { mode = 4; }
        const bool arot = (mode == 3) && ((wc & 1) == 0) && (fq < 2);
#pragma unroll
        for (int ai = 0; ai < 2; ++ai)
#pragma unroll
            for (int m = 0; m < 4; ++m) { const int row = row0 + ai * HALF + m * 16; bf16_t* rowp = O + (size_t)row * ldc + col0;
#pragma unroll
                for (int bj = 0; bj < 2; ++bj) { f32x4 v0 = acc[ai][bj][m][0], v1 = acc[ai][bj][m][1];
                    if (mode == 1 || arot) {
                        f32x4 c4, s4;
                        if (mode == 1) { const float* t = tabR + (size_t)row * 256 + 64 * bj + 16 * wc + 4 * fq; c4 = *(const f32x4*)t; s4 = *(const f32x4*)(t + 128); }
                        else { const float* t = tabA + (size_t)row * 16 + 4 * fq; c4 = *(const f32x4*)t; s4 = *(const f32x4*)(t + 8); }
                        f32x4 w0, w1;
                        w0[0] = v0[0] * c4[0] - v0[1] * s4[0]; w0[1] = v0[1] * c4[0] + v0[0] * s4[0];
                        w0[2] = v0[2] * c4[1] - v0[3] * s4[1]; w0[3] = v0[3] * c4[1] + v0[2] * s4[1];
                        w1[0] = v1[0] * c4[2] - v1[1] * s4[2]; w1[1] = v1[1] * c4[2] + v1[0] * s4[2];
                        w1[2] = v1[2] * c4[3] - v1[3] * s4[3]; w1[3] = v1[3] * c4[3] + v1[2] * s4[3];
                        v0 = w0; v1 = w1;
                    }
                    if (mode == 2) {
#pragma unroll
                        for (int i = 0; i < 4; ++i) { v0[i] = v0[i] * sigmoidf_(v0[i]); v1[i] = v1[i] * sigmoidf_(v1[i]); } }
                    if (mode == 4) {
#pragma unroll
                        for (int i = 0; i < 4; ++i) { v0[i] = sigmoidf_(v0[i]); v1[i] = sigmoidf_(v1[i]); } }
                    v0 = v0 * sc; v1 = v1 * sc;
                    u32x4 w; w.x = cvt_pk_bf16(v0[0], v0[1]); w.y = cvt_pk_bf16(v0[2], v0[3]); w.z = cvt_pk_bf16(v1[0], v1[1]); w.w = cvt_pk_bf16(v1[2], v1[3]);
                    *(u32x4*)(rowp + bj * HALF) = w; } }
    }
};
struct EpiResF32 {
    static constexpr bool PERM = false, AFTER_DRAIN = false;
    const float* base; float* out; int ldc; float alpha;
    __device__ __forceinline__ void operator()(const f32x4 (&acc)[2][2][4][2], const Unit& u, int wr, int wc, int fr, int fq) const {
        const int col0 = u.pn * BM + wc * 32 + 4 * fq;
#pragma unroll
        for (int ai = 0; ai < 2; ++ai)
#pragma unroll
            for (int m = 0; m < 4; ++m) { const size_t off = (size_t)(u.pm * BM + ai * HALF + wr * 64 + m * 16 + fr) * ldc + col0;
#pragma unroll
                for (int bj = 0; bj < 2; ++bj)
#pragma unroll
                    for (int n = 0; n < 2; ++n) { const f32x4 bs = *(const f32x4*)(base + off + bj * HALF + n * 16); *(f32x4*)(out + off + bj * HALF + n * 16) = bs * alpha + acc[ai][bj][m][n]; } }
    }
};
struct EpiSwiGLU {
    static constexpr bool PERM = true, AFTER_DRAIN = false;
    bf16_t* O; int ldc;
    __device__ __forceinline__ void operator()(const f32x4 (&acc)[2][2][4][2], const Unit& u, int wr, int wc, int fr, int fq) const {
        const int row0 = u.pm * BM + wr * 64 + fr, col0 = u.pn * HALF + wc * 32 + 8 * fq;
#pragma unroll
        for (int ai = 0; ai < 2; ++ai)
#pragma unroll
            for (int m = 0; m < 4; ++m) { bf16_t* rowp = O + (size_t)(row0 + ai * HALF + m * 16) * ldc + col0;
                f32x4 g0 = acc[ai][0][m][0], g1 = acc[ai][0][m][1]; const f32x4 u0 = acc[ai][1][m][0], u1 = acc[ai][1][m][1];
#pragma unroll
                for (int i = 0; i < 4; ++i) { g0[i] = g0[i] * sigmoidf_(g0[i]) * u0[i]; g1[i] = g1[i] * sigmoidf_(g1[i]) * u1[i]; }
                u32x4 w; w.x = cvt_pk_bf16(g0[0], g0[1]); w.y = cvt_pk_bf16(g0[2], g0[3]); w.z = cvt_pk_bf16(g1[0], g1[1]); w.w = cvt_pk_bf16(g1[2], g1[3]);
                *(u32x4*)rowp = w; }
    }
};
template <class Epi, class Sched, bool ALIGN_EPI = false, bool SP2 = false>
__device__ __forceinline__ void gemm_phase(PG8_LAS unsigned char* lds, const Gemm g, const Sched& S, const Epi& E) {
    const int tid = threadIdx.x, wid = __builtin_amdgcn_readfirstlane(tid >> 6), lane = tid & 63, wr = wid >> 2, wc = wid & 3, fr = lane & 15, fq = lane >> 4;
    const int K = g.K, nt = K / BK;
    unsigned voffA[2], voffB[2];
#pragma unroll
    for (int i = 0; i < 2; ++i) { int R, C; stage_rc(tid * 16 + i * 8192, R, C); const int Rb = Epi::PERM ? ((R & ~31) + perm32(R & 31)) : R;
        voffA[i] = (unsigned)(R * K + C) * 2u; voffB[i] = (unsigned)(Rb * K + C) * 2u; }
    const size_t kstep = (size_t)(BK * 2);
    const size_t hstep = (size_t)HALF * K * 2;
    const size_t tstep = 2 * hstep;
    const unsigned ldsw = (unsigned)wid * 1024u;
    const int aoff = lds_byte(wr * 64 + fr, fq * 8), boff = lds_byte(wc * 32 + fr, fq * 8);
#define PG8_SA(b, h) (((b) * 2 + (h)) * HTB)
#define PG8_SB(b, h) ((4 + (b) * 2 + (h)) * HTB)
#define PG8_STAGE(bufoff, gbase, voff) do { _Pragma("unroll") for (int _i = 0; _i < 2; ++_i) \
        __builtin_amdgcn_global_load_lds((const unsigned*)((const char*)(gbase) + (voff)[_i]), (PG8_LAS unsigned*)(lds + (bufoff) + ldsw + _i * 8192), 16, 0, 0); } while (0)
#define PG8_LDA(dst, b, h) do { _Pragma("unroll") for (int m = 0; m < 4; ++m) _Pragma("unroll") for (int k = 0; k < 2; ++k) dst[m][k] = *(const PG8_LAS bf16x8*)(lds + PG8_SA(b, h) + aoff + m * 2048 + k * 1024); } while (0)
#define PG8_LDB(dst, b, h) do { _Pragma("unroll") for (int n = 0; n < 2; ++n) _Pragma("unroll") for (int k = 0; k < 2; ++k) dst[n][k] = *(const PG8_LAS bf16x8*)(lds + PG8_SB(b, h) + boff + n * 2048 + k * 1024); } while (0)
#define PG8_MMA(ai, bj, At, Bt) do { __builtin_amdgcn_s_setprio(1); _Pragma("unroll") for (int m = 0; m < 4; ++m) _Pragma("unroll") for (int n = 0; n < 2; ++n) _Pragma("unroll") for (int k = 0; k < 2; ++k) \
        acc[ai][bj][m][n] = __builtin_amdgcn_mfma_f32_16x16x32_bf16(Bt[n][k], At[m][k], acc[ai][bj][m][n], 0, 0, 0); __builtin_amdgcn_s_setprio(0); } while (0)
#define PG8_WAIT_V(n) asm volatile("s_waitcnt vmcnt(" #n ")" ::: "memory")
#define PG8_WAIT_L(n) asm volatile("s_waitcnt lgkmcnt(" #n ")" ::: "memory")
#define PG8_BAR __builtin_amdgcn_s_barrier()
#define PG8_SCHED __builtin_amdgcn_sched_barrier(0)
    Unit cur, nxt; int ui = 0;
    if (!S.next(0, cur)) return;
    f32x4 acc[2][2][4][2];
#pragma unroll
    for (int a = 0; a < 2; ++a)
#pragma unroll
        for (int b = 0; b < 2; ++b)
#pragma unroll
            for (int m = 0; m < 4; ++m)
#pragma unroll
                for (int n = 0; n < 2; ++n) acc[a][b][m][n] = (f32x4){0.f, 0.f, 0.f, 0.f};
    bf16x8 At[4][2], B0[2][2], B1[2][2];
    const char* cA = (const char*)g.A + (size_t)cur.pm * tstep; const char* cB = (const char*)g.Bt + (size_t)cur.pn * tstep;
    S.a_ready(cur);
    if constexpr (SP2) {
        PG8_STAGE(PG8_SB(0, 0), cB, voffB); PG8_STAGE(PG8_SB(0, 1), cB + hstep, voffB); PG8_STAGE(PG8_SA(0, 0), cA, voffA); PG8_STAGE(PG8_SA(0, 1), cA + hstep, voffA);
        if (wr == 1) PG8_BAR;
        PG8_WAIT_V(2); PG8_BAR;
        PG8_STAGE(PG8_SB(1, 0), cB + kstep, voffB); PG8_STAGE(PG8_SA(1, 0), cA + kstep, voffA); PG8_STAGE(PG8_SB(1, 1), cB + hstep + kstep, voffB);
        PG8_WAIT_V(6); PG8_BAR;
    } else {
        PG8_STAGE(PG8_SB(0, 0), cB, voffB); PG8_STAGE(PG8_SA(0, 0), cA, voffA); PG8_STAGE(PG8_SB(0, 1), cB + hstep, voffB); PG8_STAGE(PG8_SA(0, 1), cA + hstep, voffA);
        if (wr == 1) PG8_BAR;
        PG8_WAIT_V(4); PG8_BAR;
        PG8_STAGE(PG8_SB(1, 0), cB + kstep, voffB); PG8_STAGE(PG8_SA(1, 0), cA + kstep, voffA); PG8_STAGE(PG8_SB(1, 1), cB + hstep + kstep, voffB);
        PG8_WAIT_V(6); PG8_BAR;
    }
    for (;;) {
        const bool has_next = S.next(ui + 1, nxt);
        const char* nA = has_next ? (const char*)g.A + (size_t)nxt.pm * tstep : cA; const char* nB = has_next ? (const char*)g.Bt + (size_t)nxt.pn * tstep : cB;
        for (int t = 0; t < nt; t += 2) {
            const bool last = (t == nt - 2);
            const char* a1 = cA + (size_t)(t + 1) * kstep;
            const char* a2 = last ? nA : cA + (size_t)(t + 2) * kstep; const char* b2 = last ? nB : cB + (size_t)(t + 2) * kstep;
            const char* a3 = a2 + kstep; const char* b3 = b2 + kstep;
            if (last && has_next) S.a_ready(nxt);
            if constexpr (SP2) {
            PG8_LDB(B0, 0, 0); PG8_LDB(B1, 0, 1); PG8_SCHED; PG8_LDA(At, 0, 0); PG8_STAGE(PG8_SA(1, 1), a1 + hstep, voffA);
            PG8_WAIT_V(8); PG8_WAIT_L(0); PG8_BAR; PG8_MMA(0, 0, At, B0); PG8_MMA(0, 1, At, B1); PG8_BAR; PG8_SCHED;
            PG8_LDA(At, 0, 1); PG8_STAGE(PG8_SB(0, 0), b2, voffB); PG8_STAGE(PG8_SB(0, 1), b2 + hstep, voffB); PG8_STAGE(PG8_SA(0, 0), a2, voffA);
            PG8_WAIT_V(8); PG8_WAIT_L(0); PG8_BAR; PG8_MMA(1, 0, At, B0); PG8_MMA(1, 1, At, B1); PG8_BAR; PG8_SCHED;
            PG8_LDB(B0, 1, 0); PG8_LDB(B1, 1, 1); PG8_SCHED; PG8_LDA(At, 1, 0); PG8_STAGE(PG8_SA(0, 1), a2 + hstep, voffA);
            PG8_WAIT_V(8); PG8_WAIT_L(0); PG8_BAR; PG8_MMA(0, 0, At, B0); PG8_MMA(0, 1, At, B1); PG8_BAR; PG8_SCHED;
            PG8_LDA(At, 1, 1); PG8_STAGE(PG8_SB(1, 0), b3, voffB); PG8_STAGE(PG8_SB(1, 1), b3 + hstep, voffB); PG8_STAGE(PG8_SA(1, 0), a3, voffA);
            PG8_WAIT_V(8); PG8_WAIT_L(0); PG8_BAR; PG8_MMA(1, 0, At, B0); PG8_MMA(1, 1, At, B1); PG8_BAR; PG8_SCHED;
            } else {
            PG8_LDB(B0, 0, 0); PG8_SCHED; PG8_LDA(At, 0, 0); PG8_STAGE(PG8_SA(1, 1), a1 + hstep, voffA);
            PG8_WAIT_L(8); PG8_BAR; PG8_WAIT_L(0); PG8_MMA(0, 0, At, B0); PG8_BAR; PG8_SCHED;
            PG8_LDB(B1, 0, 1); PG8_STAGE(PG8_SB(0, 0), b2, voffB);
            PG8_BAR; PG8_WAIT_L(0); PG8_MMA(0, 1, At, B1); PG8_BAR;
            PG8_LDA(At, 0, 1); PG8_STAGE(PG8_SA(0, 0), a2, voffA);
            PG8_BAR; PG8_WAIT_L(0); PG8_MMA(1, 0, At, B0); PG8_BAR; PG8_SCHED;
            PG8_STAGE(PG8_SB(0, 1), b2 + hstep, voffB);
            PG8_WAIT_V(6); PG8_BAR; PG8_MMA(1, 1, At, B1); PG8_BAR;
            PG8_LDB(B0, 1, 0); PG8_SCHED; PG8_LDA(At, 1, 0); PG8_STAGE(PG8_SA(0, 1), a2 + hstep, voffA);
            PG8_WAIT_L(8); PG8_BAR; PG8_WAIT_L(0); PG8_MMA(0, 0, At, B0); PG8_BAR; PG8_SCHED;
            PG8_LDB(B1, 1, 1); PG8_STAGE(PG8_SB(1, 0), b3, voffB);
            PG8_BAR; PG8_WAIT_L(0); PG8_MMA(0, 1, At, B1); PG8_BAR;
            PG8_LDA(At, 1, 1); PG8_STAGE(PG8_SA(1, 0), a3, voffA);
            PG8_BAR; PG8_WAIT_L(0); PG8_MMA(1, 0, At, B0); PG8_BAR; PG8_SCHED;
            PG8_STAGE(PG8_SB(1, 1), b3 + hstep, voffB);
            PG8_WAIT_V(6); PG8_BAR; PG8_MMA(1, 1, At, B1); PG8_BAR;
            }
        }
        if constexpr (ALIGN_EPI) { if (wr == 0) PG8_BAR; }
        if constexpr (!Epi::AFTER_DRAIN) { E(acc, cur, wr, wc, fr, fq); S.done(cur); }
        if (!has_next) break;
#pragma unroll
        for (int a = 0; a < 2; ++a)
#pragma unroll
            for (int b = 0; b < 2; ++b)
#pragma unroll
                for (int m = 0; m < 4; ++m)
#pragma unroll
                    for (int n = 0; n < 2; ++n) acc[a][b][m][n] = (f32x4){0.f, 0.f, 0.f, 0.f};
        cur = nxt; cA = nA; cB = nB; ++ui;
        if constexpr (ALIGN_EPI) { if (wr == 1) PG8_BAR; }
    }
    PG8_WAIT_V(0);
    if constexpr (!ALIGN_EPI) { if (wr == 0) PG8_BAR; }
    PG8_BAR;
    if constexpr (Epi::AFTER_DRAIN) { E.fused(acc, cur, wr, wc, fr, fq, lds, wid, lane); S.done(cur); }
#undef PG8_SA
#undef PG8_SB
#undef PG8_STAGE
#undef PG8_LDA
#undef PG8_LDB
#undef PG8_MMA
#undef PG8_WAIT_V
#undef PG8_WAIT_L
#undef PG8_BAR
#undef PG8_SCHED
}
}
__device__ const float INVF_R[128] = {1.000000000e+00f, 9.300450087e-01f, 8.649836779e-01f, 8.044736385e-01f, 7.481966019e-01f, 6.958565116e-01f, 6.471778154e-01f, 6.019044518e-01f, 5.597981811e-01f, 5.206375122e-01f, 4.842162728e-01f, 4.503428936e-01f, 4.188391268e-01f, 3.895392120e-01f, 3.622889817e-01f, 3.369450271e-01f, 3.133740425e-01f, 2.914519310e-01f, 2.710633874e-01f, 2.521011233e-01f, 2.344653904e-01f, 2.180633694e-01f, 2.028087080e-01f, 1.886212230e-01f, 1.754262149e-01f, 1.631542742e-01f, 1.517407894e-01f, 1.411257535e-01f, 1.312533021e-01f, 1.220714748e-01f, 1.135319397e-01f, 1.055898219e-01f, 9.820328653e-02f, 9.133346379e-02f, 8.494423330e-02f, 7.900195569e-02f, 7.347535342e-02f, 6.833537668e-02f, 6.355497986e-02f, 5.910899118e-02f, 5.497401953e-02f, 5.112830922e-02f, 4.755162448e-02f, 4.422515258e-02f, 4.113136977e-02f, 3.825402260e-02f, 3.557796404e-02f, 3.308910504e-02f, 3.077435680e-02f, 2.862153389e-02f, 2.661931701e-02f, 2.475716174e-02f, 2.302526683e-02f, 2.141453326e-02f, 1.991648041e-02f, 1.852322184e-02f, 1.722742990e-02f, 1.602228358e-02f, 1.490144618e-02f, 1.385901403e-02f, 1.288950257e-02f, 1.198781747e-02f, 1.114920899e-02f, 1.036926545e-02f, 9.643883444e-03f, 8.969245479e-03f, 8.341802284e-03f, 7.758250926e-03f, 7.215522230e-03f, 6.710760761e-03f, 6.241309457e-03f, 5.804697983e-03f, 5.398627371e-03f, 5.020966288e-03f, 4.669724498e-03f, 4.343053792e-03f, 4.039235413e-03f, 3.756670747e-03f, 3.493872471e-03f, 3.249458736e-03f, 3.022142686e-03f, 2.810728736e-03f, 2.614103956e-03f, 2.431234345e-03f, 2.261157380e-03f, 2.102978062e-03f, 1.955864020e-03f, 1.819041790e-03f, 1.691789716e-03f, 1.573440502e-03f, 1.463370281e-03f, 1.361000235e-03f, 1.265791478e-03f, 1.177242957e-03f, 1.094888896e-03f, 1.018295996e-03f, 9.470609948e-04f, 8.808093844e-04f, 8.191923262e-04f, 7.618857198e-04f, 7.085879333e-04f, 6.590186385e-04f, 6.129170069e-04f, 5.700403708e-04f, 5.301629426e-04f, 4.930753494e-04f, 4.585822753e-04f, 4.265021416e-04f, 3.966661752e-04f, 3.689173318e-04f, 3.431097430e-04f, 3.191074939e-04f, 2.967843320e-04f, 2.760227653e-04f, 2.567135962e-04f, 2.387551940e-04f, 2.220530587e-04f, 2.065193403e-04f, 1.920722716e-04f, 1.786358480e-04f, 1.661392889e-04f, 1.545170089e-04f, 1.437077590e-04f, 1.336546848e-04f, 1.243048755e-04f, 1.156091312e-04f, 1.075216787e-04f, 9.999999747e-05f};
__device__ const float INVF_A[8] = {1.000000000e+00f, 1.939227581e-01f, 3.760603070e-02f, 7.292665076e-03f, 1.414213446e-03f, 2.742481884e-04f, 5.318296462e-05f, 1.031338525e-05f};
#define LAS __attribute__((address_space(3)))
typedef unsigned short bf16_t;
typedef short bf16x8 __attribute__((ext_vector_type(8)));
typedef short s16x4 __attribute__((ext_vector_type(4)));
typedef float f32x4 __attribute__((ext_vector_type(4)));
typedef unsigned u32x4 __attribute__((ext_vector_type(4)));
typedef unsigned u32x2 __attribute__((ext_vector_type(2)));

constexpr int NB = 2, SEQ = 4096, DM = 2048, MTOK = NB * SEQ, NIN = 12800, DFF = 5632, NGU = 2 * DFF;
constexpr int C_RQ = 0, C_RK = 1024, C_RV = 2048, C_RG = 4096, C_AQ = 6144, C_AK = 8192, C_AV = 8448, C_GA = 8704, C_GB = 10752;
constexpr float ALPHA = 1.189207115002721f, LN_EPS = 1e-5f, GN_EPS = 1e-5f;
constexpr int NWAVES = 8, NTHR = 512;
constexpr int LDS_BYTES = 147456;
constexpr size_t MiB = 1u << 20;
constexpr size_t WS_WOUT = 1 * MiB, WS_WGU = 9 * MiB, WS_WDN = 53 * MiB, WS_TABR = 75 * MiB, WS_TABA = 83 * MiB;
constexpr size_t WS_WIN = 84 * MiB, WS_XB = 134 * MiB;
constexpr size_t WS_ATT = 84 * MiB, WS_PREVT = 116 * MiB;
constexpr size_t WS_PROJ = 166 * MiB;
constexpr size_t WS_MERGED = 366 * MiB, WS_END = 398 * MiB;
constexpr size_t WS_H1 = 84 * MiB, WS_H1B = 148 * MiB, WS_ACT = 180 * MiB;
static_assert(WS_WGU + (size_t)NGU * DM * 2 <= WS_WDN && WS_WDN + (size_t)DM * DFF * 2 <= WS_TABR && WS_TABR + (size_t)MTOK * 256 * 4 <= WS_TABA && WS_TABA + (size_t)MTOK * 16 * 4 <= WS_WIN, "ws map 1");
static_assert(WS_WIN + (size_t)NIN * DM * 2 <= WS_XB && WS_XB + (size_t)MTOK * DM * 2 <= WS_PROJ && WS_PROJ + (size_t)MTOK * NIN * 2 <= WS_MERGED, "ws map 2");
static_assert(WS_PREVT + (size_t)NB * 4 * 16 * 512 * 256 * 2 <= WS_PROJ && WS_ACT + (size_t)MTOK * DFF * 2 <= WS_MERGED, "ws map 3");

__device__ const float LG2G[4] = {-4.580368961312e-02f, -2.272007650008e-02f, -1.131531322783e-02f, -5.646563141142e-03f};

__device__ __forceinline__ unsigned f2bf(float f) { unsigned u = __builtin_bit_cast(unsigned, f); return (u + 0x7fffu + ((u >> 16) & 1u)) >> 16; }
__device__ __forceinline__ unsigned pk2(float lo, float hi) { return f2bf(lo) | (f2bf(hi) << 16); }
__device__ __forceinline__ float bflo(unsigned w) { return __builtin_bit_cast(float, w << 16); }
__device__ __forceinline__ float bfhi(unsigned w) { return __builtin_bit_cast(float, w & 0xffff0000u); }
typedef float f32x2_t __attribute__((ext_vector_type(2))); typedef __bf16 bf16x2_t __attribute__((ext_vector_type(2)));
__device__ __forceinline__ unsigned cvtpk(float lo, float hi) { f32x2_t v = {lo, hi}; bf16x2_t b = __builtin_convertvector(v, bf16x2_t); return __builtin_bit_cast(unsigned, b); }
__device__ __forceinline__ f32x4 mfma16(bf16x8 a, bf16x8 b, f32x4 c) { return __builtin_amdgcn_mfma_f32_16x16x32_bf16(a, b, c, 0, 0, 0); }
typedef short v4i16_t __attribute__((ext_vector_type(4)));
__device__ __forceinline__ s16x4 tr_rd(LAS const unsigned char* p) { return __builtin_bit_cast(s16x4, __builtin_amdgcn_ds_read_tr16_b64_v4i16((LAS v4i16_t*)p)); }
__device__ __forceinline__ bf16x8 cat8(s16x4 a, s16x4 b) { return (bf16x8){a[0], a[1], a[2], a[3], b[0], b[1], b[2], b[3]}; }
__device__ __forceinline__ bf16x8 pack8(f32x4 a, f32x4 b) { u32x4 w; w.x = cvtpk(a[0], a[1]); w.y = cvtpk(a[2], a[3]); w.z = cvtpk(b[0], b[1]); w.w = cvtpk(b[2], b[3]); return __builtin_bit_cast(bf16x8, w); }
__device__ __forceinline__ float wave_sum(float v) {
#pragma unroll
    for (int o = 1; o < 64; o <<= 1) v += __shfl_xor(v, o);
    return v;
}

template <int MODE> __device__ __forceinline__ int dst_row(int c) {
    if (MODE == 1) {
        if (c < 2048) { const int j = c & 255; return (c & ~255) + ((j < 128) ? 2 * j : 2 * (j - 128) + 1); }
        if (c >= C_AQ && c < C_AV) { const int j = c & 63; if (j < 16) return (c & ~63) + ((j < 8) ? 2 * j : 2 * (j - 8) + 1); }
        return c;
    }
    if (MODE == 2) return ((c >> 7) << 8) + (c & 127);
    if (MODE == 3) return ((c >> 7) << 8) + 128 + (c & 127);
    return c;
}
template <int MODE> __device__ __forceinline__ void p0_transpose_item(const float* W, int K, int N, bf16_t* WT, LAS float* scr, int item, int lane) {
    const int nblk = N / 32, kb = item / nblk, nb = item % nblk, k0 = 64 * kb, n0 = 32 * nb;
#pragma unroll 8
    for (int i = 0; i < 32; ++i) { const int kk = 2 * i + (lane >> 5); scr[kk * 33 + (lane & 31)] = W[(size_t)(k0 + kk) * N + n0 + (lane & 31)]; }
    asm volatile("s_waitcnt lgkmcnt(0)" ::: "memory");
    const int c = lane & 7;
#pragma unroll
    for (int j = 0; j < 4; ++j) { const int n = (lane >> 3) + 8 * j; const LAS float* s = scr + (8 * c) * 33 + n;
        u32x4 o; o.x = pk2(s[0 * 33], s[1 * 33]); o.y = pk2(s[2 * 33], s[3 * 33]); o.z = pk2(s[4 * 33], s[5 * 33]); o.w = pk2(s[6 * 33], s[7 * 33]);
        *(u32x4*)(WT + (size_t)dst_row<MODE>(n0 + n) * K + k0 + 8 * c) = o; }
    asm volatile("s_waitcnt lgkmcnt(0)" ::: "memory");
}

struct Args { const float* in[14]; float* out; unsigned char* ws; int ph_lo, ph_hi; };

__device__ __forceinline__ void p0_prologue(const Args& a, LAS unsigned char* lds, int gw, int NGW, int wave, int lane) {
    LAS float* scr = (LAS float*)(lds + wave * 16384);
    unsigned char* ws = a.ws;
    const float* w_in = a.in[2]; const float* w_out = a.in[6]; const float* w_gate = a.in[9]; const float* w_up = a.in[10]; const float* w_down = a.in[11];
    constexpr int I_IN = (DM / 64) * (NIN / 32), I_OUT = (DM / 64) * (DM / 32), I_G = (DM / 64) * (DFF / 32), I_D = (DFF / 64) * (DM / 32);
    constexpr int NITEMS = I_IN + I_OUT + 2 * I_G + I_D;
    for (int it = gw; it < NITEMS; it += NGW) {
        int r = it;
        if (r < I_IN) { p0_transpose_item<1>(w_in, DM, NIN, (bf16_t*)(ws + WS_WIN), scr, r, lane); continue; } r -= I_IN;
        if (r < I_OUT) { p0_transpose_item<0>(w_out, DM, DM, (bf16_t*)(ws + WS_WOUT), scr, r, lane); continue; } r -= I_OUT;
        if (r < I_G) { p0_transpose_item<2>(w_gate, DM, DFF, (bf16_t*)(ws + WS_WGU), scr, r, lane); continue; } r -= I_G;
        if (r < I_G) { p0_transpose_item<3>(w_up, DM, DFF, (bf16_t*)(ws + WS_WGU), scr, r, lane); continue; } r -= I_G;
        p0_transpose_item<0>(w_down, DFF, DM, (bf16_t*)(ws + WS_WDN), scr, r, lane);
    }
    const float* x = a.in[0]; bf16_t* xb = (bf16_t*)(ws + WS_XB);
    for (int m = gw; m < MTOK; m += NGW) {
        const f32x4* xr = (const f32x4*)(x + (size_t)m * DM) + lane; u32x2* o = (u32x2*)(xb + (size_t)m * DM) + lane;
#pragma unroll
        for (int j = 0; j < 8; ++j) { const f32x4 v = xr[64 * j]; u32x2 w; w.x = pk2(v[0], v[1]); w.y = pk2(v[2], v[3]); o[64 * j] = w; }
    }
    const int* pos = (const int*)a.in[1]; float* tabR = (float*)(ws + WS_TABR); float* tabA = (float*)(ws + WS_TABA);
    const int gt = gw * 64 + lane, NGT = NGW * 64;
    for (int i = gt; i < MTOK * 136; i += NGT) {
        const int row = i / 136, j = i % 136; const double p = (double)pos[row];
        const double fr = (j < 128) ? (double)INVF_R[j] : (double)INVF_A[j - 128];
        double t = p * fr * 0.15915494309189535; t -= __builtin_rint(t);
        const float tf = (float)t; const float cs = __builtin_amdgcn_cosf(tf), sn = __builtin_amdgcn_sinf(tf);
        if (j < 128) { tabR[(size_t)row * 256 + j] = cs; tabR[(size_t)row * 256 + 128 + j] = sn; }
        else { tabA[(size_t)row * 16 + (j - 128)] = cs; tabA[(size_t)row * 16 + 8 + (j - 128)] = sn; }
    }
}

constexpr int SC_KP = 544, SC_VP = 160, SC_VOFF = 128 * SC_KP;
__device__ __forceinline__ void scan_item(LAS unsigned char* lds, const bf16_t* proj, bf16_t* prevT, int item) {
    const int tid = threadIdx.x, lane = tid & 63, w = __builtin_amdgcn_readfirstlane(tid >> 6), fr = lane & 15, fq = lane >> 4, q4 = (lane & 15) >> 2, p4 = lane & 3;
    const int es = item & 7, h = (item >> 3) & 3, b = item >> 5;
    const float lg = LG2G[h];
    f32x4 acc[2][4];
#pragma unroll
    for (int i = 0; i < 2; ++i)
#pragma unroll
        for (int j = 0; j < 4; ++j) acc[i][j] = (f32x4){0.f, 0.f, 0.f, 0.f};
    const bf16_t* kbase = proj + (size_t)(b * SEQ) * NIN + C_RK + 256 * h;
    const bf16_t* vbase = proj + (size_t)(b * SEQ) * NIN + C_RV + 512 * h + 64 * es;
    u32x4 kr[8], vr[2];
#define SC_LOAD(step) do { const int row0_ = (step) * 128; \
    _Pragma("unroll") for (int j = 0; j < 8; ++j) { const int p = tid + 512 * j; kr[j] = *(const u32x4*)(kbase + (size_t)(row0_ + (p >> 5)) * NIN + (p & 31) * 8); } \
    _Pragma("unroll") for (int j = 0; j < 2; ++j) { const int p = tid + 512 * j; vr[j] = *(const u32x4*)(vbase + (size_t)(row0_ + (p >> 3)) * NIN + (p & 7) * 8); } } while (0)
    SC_LOAD(0);
    for (int step = 0; step < 30; ++step) {
        __syncthreads();
#pragma unroll
        for (int j = 0; j < 8; ++j) { const int p = tid + 512 * j; *(LAS u32x4*)(lds + (p >> 5) * SC_KP + (p & 31) * 16) = kr[j]; }
#pragma unroll
        for (int j = 0; j < 2; ++j) { const int p = tid + 512 * j; const int r = p >> 3; const float dc = __builtin_amdgcn_exp2f(lg * (float)(255 - ((step & 1) * 128 + r)));
            u32x4 v = vr[j], o;
            o.x = cvtpk(bflo(v.x) * dc, bfhi(v.x) * dc); o.y = cvtpk(bflo(v.y) * dc, bfhi(v.y) * dc);
            o.z = cvtpk(bflo(v.z) * dc, bfhi(v.z) * dc); o.w = cvtpk(bflo(v.w) * dc, bfhi(v.w) * dc);
            *(LAS u32x4*)(lds + SC_VOFF + r * SC_VP + (p & 7) * 16) = o; }
        __syncthreads();
        if (step + 1 < 30) SC_LOAD(step + 1);
        if ((step & 1) == 0 && step > 0) { const float cd = __builtin_amdgcn_exp2f(lg * 256.0f);
#pragma unroll
            for (int i = 0; i < 2; ++i)
#pragma unroll
                for (int j = 0; j < 4; ++j) acc[i][j] = acc[i][j] * cd; }
#pragma unroll
        for (int ks = 0; ks < 4; ++ks) {
            const int rbase = 32 * ks + 8 * fq + q4;
            bf16x8 af[2], bfr[4];
#pragma unroll
            for (int dt = 0; dt < 2; ++dt) { const LAS unsigned char* p = lds + rbase * SC_KP + (32 * w + 16 * dt + 4 * p4) * 2; af[dt] = cat8(tr_rd(p), tr_rd(p + 4 * SC_KP)); }
#pragma unroll
            for (int et = 0; et < 4; ++et) { const LAS unsigned char* p = lds + SC_VOFF + rbase * SC_VP + (16 * et + 4 * p4) * 2; bfr[et] = cat8(tr_rd(p), tr_rd(p + 4 * SC_VP)); }
#pragma unroll
            for (int dt = 0; dt < 2; ++dt)
#pragma unroll
                for (int et = 0; et < 4; ++et) acc[dt][et] = mfma16(af[dt], bfr[et], acc[dt][et]);
        }
        if (step & 1) { const int n1 = (step >> 1) + 1;
            bf16_t* ob = prevT + ((size_t)((b * 4 + h) * 16 + n1) * 512 + 64 * es) * 256;
#pragma unroll
            for (int dt = 0; dt < 2; ++dt)
#pragma unroll
                for (int et = 0; et < 4; ++et) { u32x2 o; o.x = cvtpk(acc[dt][et][0], acc[dt][et][1]); o.y = cvtpk(acc[dt][et][2], acc[dt][et][3]);
                    *(u32x2*)(ob + (size_t)(16 * et + fr) * 256 + 32 * w + 16 * dt + 4 * fq) = o; } }
    }
#undef SC_LOAD
    __syncthreads();
}

constexpr int AT_KP = 144, AT_VP = 160, AT_VOFF = 256 * AT_KP;
__device__ __forceinline__ void attn_item(LAS unsigned char* lds, const bf16_t* proj, const float* sinks, bf16_t* att, int item) {
    const int tid = threadIdx.x, lane = tid & 63, w = __builtin_amdgcn_readfirstlane(tid >> 6), fr = lane & 15, fq = lane >> 4, q4 = (lane & 15) >> 2, p4 = lane & 3;
    const int n = item & 31, kvh = (item >> 5) & 3, b = item >> 7;
    __syncthreads();
    {
        const long tok0 = (long)b * SEQ + 128 * (n - 1);
#pragma unroll
        for (int j = 0; j < 4; ++j) { const int p = tid + 512 * j, r = p >> 3, ch = p & 7;
            u32x4 kv = (u32x4){0u, 0u, 0u, 0u}, vv = (u32x4){0u, 0u, 0u, 0u};
            if (n > 0 || r >= 128) { const bf16_t* src = proj + (size_t)(tok0 + r) * NIN; kv = *(const u32x4*)(src + C_AK + 64 * kvh + ch * 8); vv = *(const u32x4*)(src + C_AV + 64 * kvh + ch * 8); }
            *(LAS u32x4*)(lds + r * AT_KP + ch * 16) = kv; *(LAS u32x4*)(lds + AT_VOFF + r * AT_VP + ch * 16) = vv; }
        if (tid < 160) *(LAS u32x4*)(lds + AT_VOFF + 256 * AT_VP + tid * 16) = (u32x4){0u, 0u, 0u, 0u};
    }
    __syncthreads();
    const int head = 8 * kvh + w;
    const float sink2 = sinks[head] * 1.4426950408889634f;
    for (int sb = 0; sb < 8; ++sb) {
        const size_t tok = (size_t)b * SEQ + 128 * n + 16 * sb + fr;
        bf16x8 qf[2];
#pragma unroll
        for (int s = 0; s < 2; ++s) qf[s] = *(const bf16x8*)(proj + tok * NIN + C_AQ + 64 * head + 32 * s + 8 * fq);
        f32x4 st[9];
#pragma unroll
        for (int t = 0; t < 9; ++t) { st[t] = (f32x4){0.f, 0.f, 0.f, 0.f};
#pragma unroll
            for (int s = 0; s < 2; ++s) { const bf16x8 kf = *(const LAS bf16x8*)(lds + (16 * (sb + t) + fr) * AT_KP + (32 * s + 8 * fq) * 2); st[t] = mfma16(kf, qf[s], st[t]); } }
        const int qi = 16 * sb + fr; float mx = -INFINITY;
#pragma unroll
        for (int t = 0; t < 9; ++t)
#pragma unroll
            for (int i = 0; i < 4; ++i) { const int kj = 16 * (sb + t) + 4 * fq + i, dist = 128 + qi - kj; const bool ok = (dist >= 0) && (dist < 128) && (n > 0 || kj >= 128);
                const float v = ok ? st[t][i] : -INFINITY; st[t][i] = v; mx = fmaxf(mx, v); }
        mx = fmaxf(mx, __shfl_xor(mx, 16)); mx = fmaxf(mx, __shfl_xor(mx, 32)); mx = fmaxf(mx, sink2);
        float sum = 0.f;
#pragma unroll
        for (int t = 0; t < 9; ++t)
#pragma unroll
            for (int i = 0; i < 4; ++i) { const float p = __builtin_amdgcn_exp2f(st[t][i] - mx); st[t][i] = p; sum += p; }
        sum += __shfl_xor(sum, 16); sum += __shfl_xor(sum, 32);
        const float rden = 1.0f / (sum + __builtin_amdgcn_exp2f(sink2 - mx));
        f32x4 o[4];
#pragma unroll
        for (int dt = 0; dt < 4; ++dt) o[dt] = (f32x4){0.f, 0.f, 0.f, 0.f};
#pragma unroll
        for (int ks = 0; ks < 5; ++ks) {
            const bf16x8 pf = pack8(st[2 * ks], (2 * ks + 1 < 9) ? st[(2 * ks + 1 < 9) ? 2 * ks + 1 : 8] : (f32x4){0.f, 0.f, 0.f, 0.f});
            const LAS unsigned char* vb = lds + AT_VOFF + (16 * (sb + 2 * ks) + 4 * fq + q4) * AT_VP + (4 * p4) * 2;
#pragma unroll
            for (int dt = 0; dt < 4; ++dt) { const bf16x8 vf = cat8(tr_rd(vb + dt * 32), tr_rd(vb + 16 * AT_VP + dt * 32)); o[dt] = mfma16(vf, pf, o[dt]); }
        }
        bf16_t* op = att + tok * DM + 64 * head + 4 * fq;
#pragma unroll
        for (int dt = 0; dt < 4; ++dt) { u32x2 ov; ov.x = cvtpk(o[dt][0] * rden, o[dt][1] * rden); ov.y = cvtpk(o[dt][2] * rden, o[dt][3] * rden); *(u32x2*)(op + 16 * dt) = ov; }
    }
}

constexpr int R3_P = 528, R3_VP = 1056, R3_VOFF = 32 * R3_P, R3_BUF = R3_VOFF + 32 * R3_VP;
static_assert(R3_BUF >= 64 * R3_P && 2 * R3_BUF <= 131072, "P3 LDS");
__device__ __forceinline__ void ret_item(LAS unsigned char* lds, const bf16_t* proj, const bf16_t* prevT, const bf16_t* att, const float* gn_g, const float* gn_b, bf16_t* merged, int item) {
    const int tid = threadIdx.x, lane = tid & 63, w = __builtin_amdgcn_readfirstlane(tid >> 6), fr = lane & 15, fq = lane >> 4, q4 = (lane & 15) >> 2, p4 = lane & 3;
    const int half = item & 1, n = (item >> 1) & 15, h = (item >> 5) & 3, b = item >> 7;
    const float lg = LG2G[h];
    const int c0 = 128 * half + 16 * w;
    const size_t tokc = (size_t)b * SEQ + 256 * n;
    bf16x8 qf[8];
#pragma unroll
    for (int s = 0; s < 8; ++s) qf[s] = *(const bf16x8*)(proj + (tokc + c0) * NIN + C_RQ + 256 * h + (unsigned)(fr * NIN + 32 * s + 8 * fq));
    f32x4 acc[32];
#pragma unroll
    for (int i = 0; i < 32; ++i) acc[i] = (f32x4){0.f, 0.f, 0.f, 0.f};
    u32x4 pr[6];
    const bf16_t* pT = prevT + (size_t)((b * 4 + h) * 16 + n) * 512 * 256;
    const bf16_t* kg = proj + tokc * NIN + C_RK + 256 * h;
    const bf16_t* vg = proj + tokc * NIN + C_RV + 512 * h;
#define R3_LOAD1(eb) do { int tq_ = tid; asm volatile("" : "+v"(tq_)); const bf16_t* b_ = pT + (size_t)(64 * (eb)) * 256; _Pragma("unroll") for (int j = 0; j < 4; ++j) { const int p = tq_ + 512 * j; pr[j] = *(const u32x4*)(b_ + (unsigned)((p >> 5) * 256 + (p & 31) * 8)); } } while (0)
#define R3_STORE1(buf) do { int tq_ = tid; asm volatile("" : "+v"(tq_)); _Pragma("unroll") for (int j = 0; j < 4; ++j) { const int p = tq_ + 512 * j; *(LAS u32x4*)((buf) + (p >> 5) * R3_P + (p & 31) * 16) = pr[j]; } } while (0)
#define R3_LOAD2(kb) do { int tq_ = tid; asm volatile("" : "+v"(tq_)); const bf16_t* kb_ = kg + (size_t)(32 * (kb)) * NIN; const bf16_t* vb_ = vg + (size_t)(32 * (kb)) * NIN; _Pragma("unroll") for (int j = 0; j < 2; ++j) { const int p = tq_ + 512 * j; pr[j] = *(const u32x4*)(kb_ + (unsigned)((p >> 5) * NIN + (p & 31) * 8)); } \
    _Pragma("unroll") for (int j = 0; j < 4; ++j) { const int p = tq_ + 512 * j; pr[2 + j] = *(const u32x4*)(vb_ + (unsigned)((p >> 6) * NIN + (p & 63) * 8)); } } while (0)
#define R3_STORE2(buf) do { int tq_ = tid; asm volatile("" : "+v"(tq_)); _Pragma("unroll") for (int j = 0; j < 2; ++j) { const int p = tq_ + 512 * j; *(LAS u32x4*)((buf) + (p >> 5) * R3_P + (p & 31) * 16) = pr[j]; } \
    _Pragma("unroll") for (int j = 0; j < 4; ++j) { const int p = tq_ + 512 * j; *(LAS u32x4*)((buf) + R3_VOFF + (p >> 6) * R3_VP + (p & 63) * 16) = pr[2 + j]; } } while (0)
    __syncthreads();
    if (n > 0) { R3_LOAD1(0); R3_STORE1(lds); } else { R3_LOAD2(0); R3_STORE2(lds); }
    __syncthreads();
    if (n > 0) {
#pragma unroll
        for (int eb = 0; eb < 8; ++eb) {
            LAS unsigned char* cur = lds + (eb & 1) * R3_BUF; LAS unsigned char* nxt = lds + ((eb + 1) & 1) * R3_BUF;
            if (eb < 7) R3_LOAD1(eb + 1); else R3_LOAD2(0);
#pragma unroll
            for (int et = 0; et < 4; ++et)
#pragma unroll
                for (int s = 0; s < 8; ++s) { const bf16x8 af = *(const LAS bf16x8*)(cur + (16 * et + fr) * R3_P + (32 * s + 8 * fq) * 2); acc[4 * eb + et] = mfma16(af, qf[s], acc[4 * eb + et]); if (s == 7) __builtin_amdgcn_sched_barrier(0); }
            if (eb < 7) R3_STORE1(nxt); else R3_STORE2(nxt);
            __syncthreads();
        }
        const float qd = __builtin_amdgcn_exp2f(lg * (float)(c0 + fr + 1));
#pragma unroll
        for (int i = 0; i < 32; ++i) acc[i] = acc[i] * qd;
    }
    const int nkb = 4 * (half + 1);
    for (int kb = 0; kb < nkb; ++kb) {
        LAS unsigned char* cur = lds + (kb & 1) * R3_BUF; LAS unsigned char* nxt = lds + ((kb + 1) & 1) * R3_BUF;
        if (kb + 1 < nkb) R3_LOAD2(kb + 1);
        if (32 * kb <= c0 + 15) {
            f32x4 st[2];
#pragma unroll
            for (int t = 0; t < 2; ++t) { st[t] = (f32x4){0.f, 0.f, 0.f, 0.f};
#pragma unroll
                for (int s = 0; s < 8; ++s) { const bf16x8 kf = *(const LAS bf16x8*)(cur + (16 * t + fr) * R3_P + (32 * s + 8 * fq) * 2); st[t] = mfma16(kf, qf[s], st[t]); } }
            const int c = c0 + fr;
#pragma unroll
            for (int t = 0; t < 2; ++t)
#pragma unroll
                for (int i = 0; i < 4; ++i) { const int dlt = c - (32 * kb + 16 * t + 4 * fq + i); st[t][i] = (dlt >= 0) ? st[t][i] * __builtin_amdgcn_exp2f(lg * (float)dlt) : 0.f; }
            const bf16x8 pf = pack8(st[0], st[1]);
            const LAS unsigned char* vb = cur + R3_VOFF + (4 * fq + q4) * R3_VP + (4 * p4) * 2;
#pragma unroll
            for (int et = 0; et < 32; ++et) { const bf16x8 vf = cat8(tr_rd(vb + et * 32), tr_rd(vb + 16 * R3_VP + et * 32)); acc[et] = mfma16(vf, pf, acc[et]); if ((et & 3) == 3) __builtin_amdgcn_sched_barrier(0); }
        }
        if (kb + 1 < nkb) R3_STORE2(nxt);
        __syncthreads();
    }
#undef R3_LOAD1
#undef R3_STORE1
#undef R3_LOAD2
#undef R3_STORE2
    float s1 = 0.f;
#pragma unroll
    for (int i = 0; i < 32; ++i) s1 += (acc[i][0] + acc[i][1]) + (acc[i][2] + acc[i][3]);
    s1 += __shfl_xor(s1, 16); s1 += __shfl_xor(s1, 32);
    const float mu = s1 * (1.0f / 512.0f); float s2 = 0.f;
#pragma unroll
    for (int i = 0; i < 32; ++i) { const f32x4 d = acc[i] - mu; s2 += (d[0] * d[0] + d[1] * d[1]) + (d[2] * d[2] + d[3] * d[3]); }
    s2 += __shfl_xor(s2, 16); s2 += __shfl_xor(s2, 32);
    const float rstd = 1.0f / sqrtf(s2 * (1.0f / 512.0f) + GN_EPS);
    const bf16_t* prow0 = proj + (tokc + c0) * NIN; const bf16_t* arow0 = att + (tokc + c0) * DM; bf16_t* mrow0 = merged + (tokc + c0) * DM;
#pragma unroll
    for (int et = 0; et < 32; ++et) { const int col = 512 * h + 16 * et + 4 * fq;
        const f32x4 gg = *(const f32x4*)(gn_g + col), gb = *(const f32x4*)(gn_b + col);
        const unsigned po = (unsigned)(fr * NIN + col), ao = (unsigned)(fr * DM + col);
        const u32x2 sg = *(const u32x2*)(prow0 + C_RG + po), ga = *(const u32x2*)(prow0 + C_GA + po), gbb = *(const u32x2*)(prow0 + C_GB + po), av = *(const u32x2*)(arow0 + ao);
        const f32x4 y = (acc[et] - mu) * rstd * gg + gb;
        const float r0 = bflo(ga.x) * (bflo(sg.x) * y[0]) + bflo(gbb.x) * bflo(av.x), r1 = bfhi(ga.x) * (bfhi(sg.x) * y[1]) + bfhi(gbb.x) * bfhi(av.x);
        const float r2 = bflo(ga.y) * (bflo(sg.y) * y[2]) + bflo(gbb.y) * bflo(av.y), r3 = bfhi(ga.y) * (bfhi(sg.y) * y[3]) + bfhi(gbb.y) * bfhi(av.y);
        u32x2 o; o.x = cvtpk(r0, r1); o.y = cvtpk(r2, r3); *(u32x2*)(mrow0 + ao) = o; if (et & 1) __builtin_amdgcn_sched_barrier(0); }
}

template <bool WB> __device__ __forceinline__ void ln_rows(const float* z, const float* g, const float* bta, float* outf, bf16_t* outb, int gw, int NGW, int lane) {
    for (int m = gw; m < MTOK; m += NGW) {
        const f32x4* zr = (const f32x4*)(z + (size_t)m * DM) + lane; f32x4 v[8]; float s = 0.f;
#pragma unroll
        for (int j = 0; j < 8; ++j) { v[j] = zr[64 * j]; s += (v[j][0] + v[j][1]) + (v[j][2] + v[j][3]); }
        const float mean = wave_sum(s) * (1.0f / DM); float s2 = 0.f;
#pragma unroll
        for (int j = 0; j < 8; ++j) { v[j] = v[j] - mean; s2 += (v[j][0] * v[j][0] + v[j][1] * v[j][1]) + (v[j][2] * v[j][2] + v[j][3] * v[j][3]); }
        const float rstd = 1.0f / sqrtf(wave_sum(s2) * (1.0f / DM) + LN_EPS);
        f32x4* of = (f32x4*)(outf + (size_t)m * DM) + lane; u32x2* ob = (u32x2*)(outb + (size_t)m * DM) + lane;
#pragma unroll
        for (int j = 0; j < 8; ++j) { const f32x4 gg = ((const f32x4*)g)[lane + 64 * j], bb = ((const f32x4*)bta)[lane + 64 * j]; const f32x4 y = v[j] * rstd * gg + bb; of[64 * j] = y;
            if (WB) { u32x2 w; w.x = pk2(y[0], y[1]); w.y = pk2(y[2], y[3]); ob[64 * j] = w; } }
    }
}

#define XB_TMO      128
#define XB_XCNT(j)  (256  + 64 * (j))
#define XB_XSUB(j)  (1280 + 64 * (j))
#define XB_XGEN(j)  (2304 + 64 * (j))
#define XB_TOP      3328
#define XB_TOPGEN   3392
#define XCD_BAR_WORDS 3456
#define XB_SPIN_CAP (1u << 18)

__device__ __forceinline__ unsigned xb_ld(unsigned* p)              { return __hip_atomic_load(p, __ATOMIC_RELAXED, __HIP_MEMORY_SCOPE_AGENT); }
__device__ __forceinline__ unsigned xb_add(unsigned* p, unsigned v) { return __hip_atomic_fetch_add(p, v, __ATOMIC_RELAXED, __HIP_MEMORY_SCOPE_AGENT); }
__device__ __forceinline__ unsigned xb_xcc_id() { return (unsigned)__builtin_amdgcn_s_getreg((3 << 11) | 20) & 0xFu; }
#define XB_SPIN(cond, bar) do { unsigned _sp = 0; while (cond) { __builtin_amdgcn_s_sleep(1); \
    if ((++_sp & 255u) == 0u) { if (xb_ld(&(bar)[XB_TMO])) break; if (_sp > XB_SPIN_CAP) { atomicAdd(&(bar)[XB_TMO], 1u); break; } } } } while (0)

struct XcdBarrier {
    unsigned* bar; unsigned x;
    volatile LAS unsigned* st;
};

__device__ __forceinline__ XcdBarrier xcd_barrier_post(unsigned* bar, volatile LAS unsigned* st) {
    XcdBarrier b; b.bar = bar; b.x = xb_xcc_id(); b.st = st;
    if (threadIdx.x == 0) (void)xb_add(&bar[XB_XCNT(b.x)], 1u);
    return b;
}
__device__ __forceinline__ void xcd_barrier_complete(unsigned* bar, unsigned x, unsigned& nloc, unsigned& nx) {
    const unsigned G = gridDim.x * gridDim.y * gridDim.z;
    unsigned sum, cnt, mine, sp = 0u;
    for (;;) {
        sum = 0u; cnt = 0u; mine = 0u;
#pragma unroll
        for (unsigned j = 0; j < 16; ++j) { const unsigned c = xb_ld(&bar[XB_XCNT(j)]); sum += c; cnt += (c > 0u) ? 1u : 0u; mine = (j == x) ? c : mine; }
        if (sum == G) break;
        __builtin_amdgcn_s_sleep(1);
        if ((++sp & 255u) == 0u) { if (xb_ld(&bar[XB_TMO])) break; if (sp > XB_SPIN_CAP) { atomicAdd(&bar[XB_TMO], 1u); break; } }
    }
    nloc = mine > 0u ? mine : 1u; nx = cnt > 0u ? cnt : 1u;
}

__device__ __forceinline__ void xcd_barrier(const XcdBarrier& b) {
    asm volatile("s_waitcnt vmcnt(0)" ::: "memory");
    __syncthreads();
    if (threadIdx.x == 0) {
        unsigned* bar = b.bar;
        __builtin_amdgcn_s_waitcnt(0);
        unsigned nloc = b.st[0], nx = b.st[1];
        if (nloc == 0u) { xcd_barrier_complete(bar, b.x, nloc, nx); b.st[0] = nloc; b.st[1] = nx; }
        const unsigned old = xb_add(&bar[XB_XSUB(b.x)], 1u);
        const unsigned gen = old / nloc;
        if (old + 1u == (gen + 1u) * nloc) {
            __builtin_amdgcn_fence(__ATOMIC_RELEASE, "agent");
            asm volatile("s_waitcnt vmcnt(0)" ::: "memory");
            const unsigned og = xb_add(&bar[XB_TOP], 1u);
            const unsigned tg = og / nx;
            if (og + 1u == (tg + 1u) * nx) xb_add(&bar[XB_TOPGEN], 1u);
            else XB_SPIN(xb_ld(&bar[XB_TOPGEN]) == tg, bar);
            __builtin_amdgcn_fence(__ATOMIC_ACQUIRE, "agent");
            xb_add(&bar[XB_XGEN(b.x)], 1u);
            asm volatile("s_waitcnt vmcnt(0)" ::: "memory");
        } else {
            XB_SPIN(xb_ld(&bar[XB_XGEN(b.x)]) == gen, bar);
            __builtin_amdgcn_fence(__ATOMIC_ACQUIRE, "agent");
            asm volatile("s_waitcnt vmcnt(0)" ::: "memory");
        }
    }
    __syncthreads();
}

#ifndef MK_PER_PHASE
#define MK_PER_PHASE 0
#endif
constexpr int N_PHASES = 9;
__global__ void __launch_bounds__(NTHR, 2) hybrid_fwd(Args args) {
    extern __shared__ __attribute__((aligned(16))) unsigned char lds_raw[];
    LAS unsigned char* lds = (LAS unsigned char*)lds_raw;
    const int tid = threadIdx.x, lane = tid & 63, wave = __builtin_amdgcn_readfirstlane(tid >> 6);
    const int G = gridDim.x, bx = blockIdx.x;
    const int gw = bx * NWAVES + wave, NGW = G * NWAVES;
    unsigned char* ws = args.ws;
    bf16_t* proj = (bf16_t*)(ws + WS_PROJ); bf16_t* attb = (bf16_t*)(ws + WS_ATT); bf16_t* prevT = (bf16_t*)(ws + WS_PREVT); bf16_t* merged = (bf16_t*)(ws + WS_MERGED);
    float* zbuf = args.out; float* h1 = (float*)(ws + WS_H1); bf16_t* h1b = (bf16_t*)(ws + WS_H1B); bf16_t* actb = (bf16_t*)(ws + WS_ACT);
    const int lo = args.ph_lo, hi = args.ph_hi;
    volatile LAS unsigned* misc = (volatile LAS unsigned*)(lds + 131072 + 8192);
    unsigned* ctl = (unsigned*)ws;
    int vcu = bx;
#if !MK_PER_PHASE
    if (args.ph_hi > 1000) cg::this_grid().sync();
    if (tid < 16) misc[tid] = 0u;
    __syncthreads();
    XcdBarrier xbar = xcd_barrier_post(ctl + 4096, misc + 8);
    if (tid == 0) { const unsigned x = (unsigned)__builtin_amdgcn_s_getreg((3 << 11) | 20) & 0xFu; misc[0] = x; misc[1] = __hip_atomic_fetch_add(ctl + 64 * x, 1u, __ATOMIC_RELAXED, __HIP_MEMORY_SCOPE_AGENT); }
#endif
#ifndef PH_MASK
#define PH_MASK 0x1ff
#endif
#define IN(k) ((((PH_MASK) >> (k)) & 1) && lo <= (k) && (k) < hi)
#if MK_PER_PHASE
#define GRID_BAR() do { } while (0)
#else
#define GRID_BAR() do { xcd_barrier(xbar); } while (0)
#endif
    if (IN(0)) { p0_prologue(args, lds, gw, NGW, wave, lane); if (IN(1)) GRID_BAR(); }
#if !MK_PER_PHASE
    if (tid == 0) { bool even = (G % 8 == 0); for (int j = 0; j < 16; ++j) { const unsigned c = __hip_atomic_load(ctl + 64 * j, __ATOMIC_RELAXED, __HIP_MEMORY_SCOPE_AGENT); if (c != (j < 8 ? (unsigned)G / 8u : 0u)) even = false; }
        misc[2] = even ? misc[1] * 8u + misc[0] : (unsigned)bx; }
    __syncthreads();
    vcu = (int)misc[2];
    vcu = __builtin_amdgcn_readfirstlane(vcu);
#endif
    if (IN(1)) {
        pg8::Gemm g{(const bf16_t*)(ws + WS_XB), (const bf16_t*)(ws + WS_WIN), MTOK, NIN, DM}; pg8::StaticOrder S; S.init(MTOK, NIN, G, vcu);
        pg8::EpiInProj E{proj, (const float*)(ws + WS_TABR), (const float*)(ws + WS_TABA)};
        pg8::gemm_phase<pg8::EpiInProj, pg8::StaticOrder, true, true>(lds, g, S, E);
        if (IN(2)) GRID_BAR();
    }
    if (IN(2)) {
        for (int it = vcu; it < 64 + 256; it += G) { if (it < 64) scan_item(lds, proj, prevT, it); else attn_item(lds, proj, args.in[5], attb, it - 64); }
        if (IN(3)) GRID_BAR();
    }
    if (IN(3)) {
        for (int it = vcu; it < 256; it += G) ret_item(lds, proj, prevT, attb, args.in[3], args.in[4], merged, it);
        __syncthreads();
        if (IN(4)) GRID_BAR();
    }
    if (IN(4)) {
        pg8::Gemm g{merged, (const bf16_t*)(ws + WS_WOUT), MTOK, DM, DM}; pg8::StaticOrder S; S.init(MTOK, DM, G, vcu);
        pg8::EpiResF32 E{args.in[0], zbuf, DM, ALPHA};
        pg8::gemm_phase<pg8::EpiResF32, pg8::StaticOrder, true, true>(lds, g, S, E);
        if (IN(5)) GRID_BAR();
    }
    if (IN(5)) { ln_rows<true>(zbuf, args.in[7], args.in[8], h1, h1b, gw, NGW, lane); if (IN(6)) GRID_BAR(); }
    if (IN(6)) {
        pg8::Gemm g{h1b, (const bf16_t*)(ws + WS_WGU), MTOK, NGU, DM}; pg8::StaticOrder S; S.init(MTOK, NGU, G, vcu);
        pg8::EpiSwiGLU E{actb, DFF};
        pg8::gemm_phase<pg8::EpiSwiGLU, pg8::StaticOrder, true, true>(lds, g, S, E);
        if (IN(7)) GRID_BAR();
    }
    if (IN(7)) {
        pg8::Gemm g{actb, (const bf16_t*)(ws + WS_WDN), MTOK, DM, DFF}; pg8::StaticOrder S; S.init(MTOK, DM, G, vcu);
        pg8::EpiResF32 E{h1, zbuf, DM, ALPHA};
        pg8::gemm_phase<pg8::EpiResF32, pg8::StaticOrder, true, true>(lds, g, S, E);
        if (IN(8)) GRID_BAR();
    }
    if (IN(8)) { ln_rows<false>(zbuf, args.in[12], args.in[13], args.out, nullptr, gw, NGW, lane); }
#undef IN
#undef GRID_BAR
}

#ifndef DBG_STOP
#define DBG_STOP 0
#endif
__global__ void dbg_dump(const unsigned short* src, int pitch, float* out) {
    const size_t i = (size_t)blockIdx.x * blockDim.x + threadIdx.x;
    const size_t r = i / DM, c = i % DM;
    float acc = 0.f;
    for (size_t cc = c; cc < (size_t)pitch; cc += DM) acc += __builtin_bit_cast(float, (unsigned)src[r * pitch + cc] << 16);
    out[i] = acc;
}
extern "C" void kernel_launch(void* const* d_in, const int* in_sizes, int n_in, void* d_out, int out_size, void* d_ws, size_t ws_size, hipStream_t stream) {
    static int grid = 0;
    if (grid == 0) {
        if (n_in != 14 || in_sizes[0] != MTOK * DM || out_size != MTOK * DM || ws_size < WS_END) { fprintf(stderr, "kernel_launch: unexpected shapes / workspace (n_in %d, ws %zu, need %zu)\n", n_in, ws_size, (size_t)WS_END); grid = -1; return; }
        int dev = 0, cus = 0, per_cu = 0;
        if (hipGetDevice(&dev) != hipSuccess || hipDeviceGetAttribute(&cus, hipDeviceAttributeMultiprocessorCount, dev) != hipSuccess) { grid = -1; return; }
        if (hipFuncSetAttribute((const void*)hybrid_fwd, hipFuncAttributeMaxDynamicSharedMemorySize, LDS_BYTES) != hipSuccess) { fprintf(stderr, "kernel_launch: hipFuncSetAttribute failed\n"); grid = -1; return; }
        if (hipOccupancyMaxActiveBlocksPerMultiprocessor(&per_cu, (const void*)hybrid_fwd, NTHR, LDS_BYTES) != hipSuccess || per_cu < 1) { fprintf(stderr, "kernel_launch: occupancy query gave %d\n", per_cu); per_cu = 1; }
        (void)hipGetLastError();
        grid = cus * per_cu;
    }
    if (grid < 0) return;
    Args a{};
    for (int i = 0; i < 14; ++i) a.in[i] = (const float*)d_in[i];
    a.out = (float*)d_out; a.ws = (unsigned char*)d_ws;
#if MK_PER_PHASE
    const int np_ = DBG_STOP ? DBG_STOP + 1 : N_PHASES;
    for (int p = 0; p < np_; ++p) { a.ph_lo = p; a.ph_hi = p + 1; hipLaunchKernelGGL(hybrid_fwd, dim3(grid), dim3(NTHR), LDS_BYTES, stream, a); }
    if (DBG_STOP == 1) hipLaunchKernelGGL(dbg_dump, dim3(MTOK * DM / 256), dim3(256), 0, stream, (const unsigned short*)((unsigned char*)d_ws + WS_PROJ), NIN, (float*)d_out);
    if (DBG_STOP == 2) hipLaunchKernelGGL(dbg_dump, dim3(MTOK * DM / 256), dim3(256), 0, stream, (const unsigned short*)((unsigned char*)d_ws + WS_PREVT), DM, (float*)d_out);
    if (DBG_STOP == 3) hipLaunchKernelGGL(dbg_dump, dim3(MTOK * DM / 256), dim3(256), 0, stream, (const unsigned short*)((unsigned char*)d_ws + WS_MERGED), DM, (float*)d_out);
    if (DBG_STOP == 6) hipLaunchKernelGGL(dbg_dump, dim3(MTOK * DM / 256), dim3(256), 0, stream, (const unsigned short*)((unsigned char*)d_ws + WS_ACT), DFF, (float*)d_out);
#else
    a.ph_lo = 0; a.ph_hi = N_PHASES;
    (void)hipMemsetAsync(d_ws, 0, 65536, stream);
    void* kargs[] = {&a};
    hipError_t e = hipLaunchCooperativeKernel((const void*)hybrid_fwd, dim3(grid), dim3(NTHR), kargs, LDS_BYTES, stream);
    if (e != hipSuccess) fprintf(stderr, "cooperative launch failed: %s (grid %d)\n", hipGetErrorString(e), grid);
#endif
}
```

```cpp
#include <hip/hip_runtime.h>
#include <hip/hip_cooperative_groups.h>
#include <cstdio>
#include <cstdint>
namespace cg = cooperative_groups;
namespace pg8 {
#define PG8_LAS __attribute__((address_space(3)))
typedef unsigned short bf16_t;
typedef short bf16x8 __attribute__((ext_vector_type(8)));
typedef float f32x4 __attribute__((ext_vector_type(4)));
typedef unsigned u32x4 __attribute__((ext_vector_type(4)));
constexpr int BM = 256, BK = 64, HALF = 128, HTB = HALF * BK * 2  , STAGE_BYTES = 8 * HTB, NXCD = 8, WGM = 8;

__host__ __device__ __forceinline__ int lds_byte(int r, int c) { const int st = (r >> 4) * 2 + (c >> 5), rr = r & 15, cc = c & 31, ob = rr * 64 + cc * 2; return st * 1024 + (ob ^ (((ob >> 9) & 1) << 5)); }
__host__ __device__ __forceinline__ void stage_rc(int b, int& R, int& C) { const int st = b / 1024, sb = b % 1024, swz = sb ^ (((sb >> 9) & 1) << 5); R = (st >> 1) * 16 + swz / 64; C = (st & 1) * 32 + (swz % 64) / 2; }
__host__ __device__ __forceinline__ int perm32(int rho) { const int n = rho >> 4, i = rho & 15; return 8 * (i >> 2) + 4 * n + (i & 3); }

struct Unit { int pm, pn; };
struct Gemm { const bf16_t* A; const bf16_t* Bt; int M, N, K; };

struct StaticOrder {
    int nM, nN, nwg, G, c;
    __host__ __device__ void init(int M, int N, int G_, int c_) { nM = M / BM; nN = N / BM; nwg = nM * nN; G = G_; c = c_; }
    __host__ __device__ bool next(int i, Unit& u) const {
        const long L = (long)i * G + c; if (L >= nwg) return false;
        int wgid = (int)L; { const int q = nwg / NXCD, r = nwg % NXCD, xcd = wgid % NXCD, off = wgid / NXCD; wgid = (xcd < r ? xcd * (q + 1) : r * (q + 1) + (xcd - r) * q) + off; }
        const int nig = WGM * nN, gid = wgid / nig, fm = gid * WGM, gsz = (nM - fm) < WGM ? (nM - fm) : WGM;
        u.pm = fm + ((wgid % nig) % gsz); u.pn = (wgid % nig) / gsz; return true;
    }
    __device__ __forceinline__ void a_ready(const Unit&) const {}
    __device__ __forceinline__ void done(const Unit&) const {}
};

__device__ __forceinline__ unsigned cvt_pk_bf16(float lo, float hi) { unsigned r; asm volatile("v_cvt_pk_bf16_f32 %0, %1, %2" : "=v"(r) : "v"(lo), "v"(hi)); return r; }
typedef float f32x2 __attribute__((ext_vector_type(2)));
struct RoundRange {
    StaticOrder S; int i0, i1; bool swap;
    __device__ __forceinline__ bool next(int i, Unit& u) const { if (i0 + i >= i1) return false; if (!S.next(i0 + i, u)) return false; if (swap) u.pn = (u.pn == 24) ? 48 : (u.pn == 48) ? 24 : u.pn; return true; }
    __device__ __forceinline__ void a_ready(const Unit&) const {}
    __device__ __forceinline__ void done(const Unit&) const {}
};
__device__ __forceinline__ float sigmoidf_(float x) { return __builtin_amdgcn_rcpf(1.0f + __expf(-x)); }
struct EpiInProj {
    static constexpr bool PERM = true, AFTER_DRAIN = false;
    bf16_t* O; const float* tabR; const float* tabA;
    __device__ __forceinline__ void operator()(const f32x4 (&acc)[2][2][4][2], const Unit& u, int wr, int wc, int fr, int fq) const {
        const int pn = u.pn, ldc = 12800;
        const int row0 = u.pm * BM + wr * 64 + fr, col0 = pn * BM + wc * 32 + 8 * fq;
        int mode; float sc = 1.f;
        if (pn < 4) { mode = 1; sc = 0.0625f; } else if (pn < 8) { mode = 1; } else if (pn < 16) { mode = 0; } else if (pn < 24) { mode = 2; }
        else if (pn < 32) { mode = 3; sc = 0.18033688011112042f; } else if (pn == 32) { mode = 3; } else if (pn == 33) { mode = 0; } else { mode = 4; }
        const bool arot = (mode == 3) && ((wc & 1) == 0) && (fq < 2);
#pragma unroll
        for (int ai = 0; ai < 2; ++ai)
#pragma unroll
            for (int m = 0; m < 4; ++m) { const int row = row0 + ai * HALF + m * 16; bf16_t* rowp = O + (size_t)row * ldc + col0;
#pragma unroll
                for (int bj = 0; bj < 2; ++bj) { f32x4 v0 = acc[ai][bj][m][0], v1 = acc[ai][bj][m][1];
                    if (mode == 1 || arot) {
                        f32x4 c4, s4;
                        if (mode == 1) { const float* t = tabR + (size_t)row * 256 + 64 * bj + 16 * wc + 4 * fq; c4 = *(const f32x4*)t; s4 = *(const f32x4*)(t + 128); }
                        else { const float* t = tabA + (size_t)row * 16 + 4 * fq; c4 = *(const f32x4*)t; s4 = *(const f32x4*)(t + 8); }
                        f32x4 w0, w1;
                        w0[0] = v0[0] * c4[0] - v0[1] * s4[0]; w0[1] = v0[1] * c4[0] + v0[0] * s4[0];
                        w0[2] = v0[2] * c4[1] - v0[3] * s4[1]; w0[3] = v0[3] * c4[1] + v0[2] * s4[1];
                        w1[0] = v1[0] * c4[2] - v1[1] * s4[2]; w1[1] = v1[1] * c4[2] + v1[0] * s4[2];
                        w1[2] = v1[2] * c4[3] - v1[3] * s4[3]; w1[3] = v1[3] * c4[3] + v1[2] * s4[3];
                        v0 = w0; v1 = w1;
                    }
                    if (mode == 2) {
#pragma unroll
                        for (int i = 0; i < 4; ++i) { v0[i] = v0[i] * sigmoidf_(v0[i]); v1[i] = v1[i] * sigmoidf_(v1[i]); } }
                    if (mode == 4) {
#pragma unroll
                        for (int i = 0; i < 4; ++i) { v0[i] = sigmoidf_(v0[i]); v1[i] = sigmoidf_(v1[i]); } }
                    v0 = v0 * sc; v1 = v1 * sc;
                    u32x4 w; w.x = cvt_pk_bf16(v0[0], v0[1]); w.y = cvt_pk_bf16(v0[2], v0[3]); w.z = cvt_pk_bf16(v1[0], v1[1]); w.w = cvt_pk_bf16(v1[2], v1[3]);
                    *(u32x4*)(rowp + bj * HALF) = w; } }
    }
};
struct EpiResF32 {
    static constexpr bool PERM = false, AFTER_DRAIN = false;
    const float* base; float* out; int ldc; float alpha;
    __device__ __forceinline__ void operator()(const f32x4 (&acc)[2][2][4][2], const Unit& u, int wr, int wc, int fr, int fq) const {
        const int col0 = u.pn * BM + wc * 32 + 4 * fq;
#pragma unroll
        for (int ai = 0; ai < 2; ++ai)
#pragma unroll
            for (int m = 0; m < 4; ++m) { const size_t off = (size_t)(u.pm * BM + ai * HALF + wr * 64 + m * 16 + fr) * ldc + col0;
#pragma unroll
                for (int bj = 0; bj < 2; ++bj)
#pragma unroll
                    for (int n = 0; n < 2; ++n) { const f32x4 bs = *(const f32x4*)(base + off + bj * HALF + n * 16); *(f32x4*)(out + off + bj * HALF + n * 16) = bs * alpha + acc[ai][bj][m][n]; } }
    }
};
struct EpiSwiGLU {
    static constexpr bool PERM = true, AFTER_DRAIN = false;
    bf16_t* O; int ldc;
    __device__ __forceinline__ void operator()(const f32x4 (&acc)[2][2][4][2], const Unit& u, int wr, int wc, int fr, int fq) const {
        const int row0 = u.pm * BM + wr * 64 + fr, col0 = u.pn * HALF + wc * 32 + 8 * fq;
#pragma unroll
        for (int ai = 0; ai < 2; ++ai)
#pragma unroll
            for (int m = 0; m < 4; ++m) { bf16_t* rowp = O + (size_t)(row0 + ai * HALF + m * 16) * ldc + col0;
                f32x4 g0 = acc[ai][0][m][0], g1 = acc[ai][0][m][1]; const f32x4 u0 = acc[ai][1][m][0], u1 = acc[ai][1][m][1];
#pragma unroll
                for (int i = 0; i < 4; ++i) { g0[i] = g0[i] * sigmoidf_(g0[i]) * u0[i]; g1[i] = g1[i] * sigmoidf_(g1[i]) * u1[i]; }
                u32x4 w; w.x = cvt_pk_bf16(g0[0], g0[1]); w.y = cvt_pk_bf16(g0[2], g0[3]); w.z = cvt_pk_bf16(g1[0], g1[1]); w.w = cvt_pk_bf16(g1[2], g1[3]);
                *(u32x4*)rowp = w; }
    }
};
template <class Epi, class Sched, bool ALIGN_EPI = false, bool SP2 = false>
__device__ __forceinline__ void gemm_phase(PG8_LAS unsigned char* lds, const Gemm g, const Sched& S, const Epi& E) {
    const int tid = threadIdx.x, wid = __builtin_amdgcn_readfirstlane(tid >> 6), lane = tid & 63, wr = wid >> 2, wc = wid & 3, fr = lane & 15, fq = lane >> 4;
    const int K = g.K, nt = K / BK;
    unsigned voffA[2], voffB[2];
#pragma unroll
    for (int i = 0; i < 2; ++i) { int R, C; stage_rc(tid * 16 + i * 8192, R, C); const int Rb = Epi::PERM ? ((R & ~31) + perm32(R & 31)) : R;
        voffA[i] = (unsigned)(R * K + C) * 2u; voffB[i] = (unsigned)(Rb * K + C) * 2u; }
    const size_t kstep = (size_t)(BK * 2);
    const size_t hstep = (size_t)HALF * K * 2;
    const size_t tstep = 2 * hstep;
    const unsigned ldsw = (unsigned)wid * 1024u;
    const int aoff = lds_byte(wr * 64 + fr, fq * 8), boff = lds_byte(wc * 32 + fr, fq * 8);
#define PG8_SA(b, h) (((b) * 2 + (h)) * HTB)
#define PG8_SB(b, h) ((4 + (b) * 2 + (h)) * HTB)
#define PG8_STAGE(bufoff, gbase, voff) do { _Pragma("unroll") for (int _i = 0; _i < 2; ++_i) \
        __builtin_amdgcn_global_load_lds((const unsigned*)((const char*)(gbase) + (voff)[_i]), (PG8_LAS unsigned*)(lds + (bufoff) + ldsw + _i * 8192), 16, 0, 0); } while (0)
#define PG8_LDA(dst, b, h) do { _Pragma("unroll") for (int m = 0; m < 4; ++m) _Pragma("unroll") for (int k = 0; k < 2; ++k) dst[m][k] = *(const PG8_LAS bf16x8*)(lds + PG8_SA(b, h) + aoff + m * 2048 + k * 1024); } while (0)
#define PG8_LDB(dst, b, h) do { _Pragma("unroll") for (int n = 0; n < 2; ++n) _Pragma("unroll") for (int k = 0; k < 2; ++k) dst[n][k] = *(const PG8_LAS bf16x8*)(lds + PG8_SB(b, h) + boff + n * 2048 + k * 1024); } while (0)
#define PG8_MMA(ai, bj, At, Bt) do { __builtin_amdgcn_s_setprio(1); _Pragma("unroll") for (int m = 0; m < 4; ++m) _Pragma("unroll") for (int n = 0; n < 2; ++n) _Pragma("unroll") for (int k = 0; k < 2; ++k) \
        acc[ai][bj][m][n] = __builtin_amdgcn_mfma_f32_16x16x32_bf16(Bt[n][k], At[m][k], acc[ai][bj][m][n], 0, 0, 0); __builtin_amdgcn_s_setprio(0); } while (0)
#define PG8_WAIT_V(n) asm volatile("s_waitcnt vmcnt(" #n ")" ::: "memory")
#define PG8_WAIT_L(n) asm volatile("s_waitcnt lgkmcnt(" #n ")" ::: "memory")
#define PG8_BAR __builtin_amdgcn_s_barrier()
#define PG8_SCHED __builtin_amdgcn_sched_barrier(0)
    Unit cur, nxt; int ui = 0;
    if (!S.next(0, cur)) return;
    f32x4 acc[2][2][4][2];
#pragma unroll
    for (int a = 0; a < 2; ++a)
#pragma unroll
        for (int b = 0; b < 2; ++b)
#pragma unroll
            for (int m = 0; m < 4; ++m)
#pragma unroll
                for (int n = 0; n < 2; ++n) acc[a][b][m][n] = (f32x4){0.f, 0.f, 0.f, 0.f};
    bf16x8 At[4][2], B0[2][2], B1[2][2];
    const char* cA = (const char*)g.A + (size_t)cur.pm * tstep; const char* cB = (const char*)g.Bt + (size_t)cur.pn * tstep;
    S.a_ready(cur);
    if constexpr (SP2) {
        PG8_STAGE(PG8_SB(0, 0), cB, voffB); PG8_STAGE(PG8_SB(0, 1), cB + hstep, voffB); PG8_STAGE(PG8_SA(0, 0), cA, voffA); PG8_STAGE(PG8_SA(0, 1), cA + hstep, voffA);
        if (wr == 1) PG8_BAR;
        PG8_WAIT_V(2); PG8_BAR;
        PG8_STAGE(PG8_SB(1, 0), cB + kstep, voffB); PG8_STAGE(PG8_SA(1, 0), cA + kstep, voffA); PG8_STAGE(PG8_SB(1, 1), cB + hstep + kstep, voffB);
        PG8_WAIT_V(6); PG8_BAR;
    } else {
        PG8_STAGE(PG8_SB(0, 0), cB, voffB); PG8_STAGE(PG8_SA(0, 0), cA, voffA); PG8_STAGE(PG8_SB(0, 1), cB + hstep, voffB); PG8_STAGE(PG8_SA(0, 1), cA + hstep, voffA);
        if (wr == 1) PG8_BAR;
        PG8_WAIT_V(4); PG8_BAR;
        PG8_STAGE(PG8_SB(1, 0), cB + kstep, voffB); PG8_STAGE(PG8_SA(1, 0), cA + kstep, voffA); PG8_STAGE(PG8_SB(1, 1), cB + hstep + kstep, voffB);
        PG8_WAIT_V(6); PG8_BAR;
    }
    for (;;) {
        const bool has_next = S.next(ui + 1, nxt);
        const char* nA = has_next ? (const char*)g.A + (size_t)nxt.pm * tstep : cA; const char* nB = has_next ? (const char*)g.Bt + (size_t)nxt.pn * tstep : cB;
        for (int t = 0; t < nt; t += 2) {
            const bool last = (t == nt - 2);
            const char* a1 = cA + (size_t)(t + 1) * kstep;
            const char* a2 = last ? nA : cA + (size_t)(t + 2) * kstep; const char* b2 = last ? nB : cB + (size_t)(t + 2) * kstep;
            const char* a3 = a2 + kstep; const char* b3 = b2 + kstep;
            if (last && has_next) S.a_ready(nxt);
            if constexpr (SP2) {
            PG8_LDB(B0, 0, 0); PG8_LDB(B1, 0, 1); PG8_SCHED; PG8_LDA(At, 0, 0); PG8_STAGE(PG8_SA(1, 1), a1 + hstep, voffA);
            PG8_WAIT_V(8); PG8_WAIT_L(0); PG8_BAR; PG8_MMA(0, 0, At, B0); PG8_MMA(0, 1, At, B1); PG8_BAR; PG8_SCHED;
            PG8_LDA(At, 0, 1); PG8_STAGE(PG8_SB(0, 0), b2, voffB); PG8_STAGE(PG8_SB(0, 1), b2 + hstep, voffB); PG8_STAGE(PG8_SA(0, 0), a2, voffA);
            PG8_WAIT_V(8); PG8_WAIT_L(0); PG8_BAR; PG8_MMA(1, 0, At, B0); PG8_MMA(1, 1, At, B1); PG8_BAR; PG8_SCHED;
            PG8_LDB(B0, 1, 0); PG8_LDB(B1, 1, 1); PG8_SCHED; PG8_LDA(At, 1, 0); PG8_STAGE(PG8_SA(0, 1), a2 + hstep, voffA);
            PG8_WAIT_V(8); PG8_WAIT_L(0); PG8_BAR; PG8_MMA(0, 0, At, B0); PG8_MMA(0, 1, At, B1); PG8_BAR; PG8_SCHED;
            PG8_LDA(At, 1, 1); PG8_STAGE(PG8_SB(1, 0), b3, voffB); PG8_STAGE(PG8_SB(1, 1), b3 + hstep, voffB); PG8_STAGE(PG8_SA(1, 0), a3, voffA);
            PG8_WAIT_V(8); PG8_WAIT_L(0); PG8_BAR; PG8_MMA(1, 0, At, B0); PG8_MMA(1, 1, At, B1); PG8_BAR; PG8_SCHED;
            } else {
            PG8_LDB(B0, 0, 0); PG8_SCHED; PG8_LDA(At, 0, 0); PG8_STAGE(PG8_SA(1, 1), a1 + hstep, voffA);
            PG8_WAIT_L(8); PG8_BAR; PG8_WAIT_L(0); PG8_MMA(0, 0, At, B0); PG8_BAR; PG8_SCHED;
            PG8_LDB(B1, 0, 1); PG8_STAGE(PG8_SB(0, 0), b2, voffB);
            PG8_BAR; PG8_WAIT_L(0); PG8_MMA(0, 1, At, B1); PG8_BAR;
            PG8_LDA(At, 0, 1); PG8_STAGE(PG8_SA(0, 0), a2, voffA);
            PG8_BAR; PG8_WAIT_L(0); PG8_MMA(1, 0, At, B0); PG8_BAR; PG8_SCHED;
            PG8_STAGE(PG8_SB(0, 1), b2 + hstep, voffB);
            PG8_WAIT_V(6); PG8_BAR; PG8_MMA(1, 1, At, B1); PG8_BAR;
            PG8_LDB(B0, 1, 0); PG8_SCHED; PG8_LDA(At, 1, 0); PG8_STAGE(PG8_SA(0, 1), a2 + hstep, voffA);
            PG8_WAIT_L(8); PG8_BAR; PG8_WAIT_L(0); PG8_MMA(0, 0, At, B0); PG8_BAR; PG8_SCHED;
            PG8_LDB(B1, 1, 1); PG8_STAGE(PG8_SB(1, 0), b3, voffB);
            PG8_BAR; PG8_WAIT_L(0); PG8_MMA(0, 1, At, B1); PG8_BAR;
            PG8_LDA(At, 1, 1); PG8_STAGE(PG8_SA(1, 0), a3, voffA);
            PG8_BAR; PG8_WAIT_L(0); PG8_MMA(1, 0, At, B0); PG8_BAR; PG8_SCHED;
            PG8_STAGE(PG8_SB(1, 1), b3 + hstep, voffB);
            PG8_WAIT_V(6); PG8_BAR; PG8_MMA(1, 1, At, B1); PG8_BAR;
            }
        }
        if constexpr (ALIGN_EPI) { if (wr == 0) PG8_BAR; }
        if constexpr (!Epi::AFTER_DRAIN) { E(acc, cur, wr, wc, fr, fq); S.done(cur); }
        if (!has_next) break;
#pragma unroll
        for (int a = 0; a < 2; ++a)
#pragma unroll
            for (int b = 0; b < 2; ++b)
#pragma unroll
                for (int m = 0; m < 4; ++m)
#pragma unroll
                    for (int n = 0; n < 2; ++n) acc[a][b][m][n] = (f32x4){0.f, 0.f, 0.f, 0.f};
        cur = nxt; cA = nA; cB = nB; ++ui;
        if constexpr (ALIGN_EPI) { if (wr == 1) PG8_BAR; }
    }
    PG8_WAIT_V(0);
    if constexpr (!ALIGN_EPI) { if (wr == 0) PG8_BAR; }
    PG8_BAR;
    if constexpr (Epi::AFTER_DRAIN) { E.fused(acc, cur, wr, wc, fr, fq, lds, wid, lane); S.done(cur); }
#undef PG8_SA
#undef PG8_SB
#undef PG8_STAGE
#undef PG8_LDA
#undef PG8_LDB
#undef PG8_MMA
#undef PG8_WAIT_V
#undef PG8_WAIT_L
#undef PG8_BAR
#undef PG8_SCHED
}
}
__device__ const float INVF_R[128] = {1.000000000e+00f, 9.300450087e-01f, 8.649836779e-01f, 8.044736385e-01f, 7.481966019e-01f, 6.958565116e-01f, 6.471778154e-01f, 6.019044518e-01f, 5.597981811e-01f, 5.206375122e-01f, 4.842162728e-01f, 4.503428936e-01f, 4.188391268e-01f, 3.895392120e-01f, 3.622889817e-01f, 3.369450271e-01f, 3.133740425e-01f, 2.914519310e-01f, 2.710633874e-01f, 2.521011233e-01f, 2.344653904e-01f, 2.180633694e-01f, 2.028087080e-01f, 1.886212230e-01f, 1.754262149e-01f, 1.631542742e-01f, 1.517407894e-01f, 1.411257535e-01f, 1.312533021e-01f, 1.220714748e-01f, 1.135319397e-01f, 1.055898219e-01f, 9.820328653e-02f, 9.133346379e-02f, 8.494423330e-02f, 7.900195569e-02f, 7.347535342e-02f, 6.833537668e-02f, 6.355497986e-02f, 5.910899118e-02f, 5.497401953e-02f, 5.112830922e-02f, 4.755162448e-02f, 4.422515258e-02f, 4.113136977e-02f, 3.825402260e-02f, 3.557796404e-02f, 3.308910504e-02f, 3.077435680e-02f, 2.862153389e-02f, 2.661931701e-02f, 2.475716174e-02f, 2.302526683e-02f, 2.141453326e-02f, 1.991648041e-02f, 1.852322184e-02f, 1.722742990e-02f, 1.602228358e-02f, 1.490144618e-02f, 1.385901403e-02f, 1.288950257e-02f, 1.198781747e-02f, 1.114920899e-02f, 1.036926545e-02f, 9.643883444e-03f, 8.969245479e-03f, 8.341802284e-03f, 7.758250926e-03f, 7.215522230e-03f, 6.710760761e-03f, 6.241309457e-03f, 5.804697983e-03f, 5.398627371e-03f, 5.020966288e-03f, 4.669724498e-03f, 4.343053792e-03f, 4.039235413e-03f, 3.756670747e-03f, 3.493872471e-03f, 3.249458736e-03f, 3.022142686e-03f, 2.810728736e-03f, 2.614103956e-03f, 2.431234345e-03f, 2.261157380e-03f, 2.102978062e-03f, 1.955864020e-03f, 1.819041790e-03f, 1.691789716e-03f, 1.573440502e-03f, 1.463370281e-03f, 1.361000235e-03f, 1.265791478e-03f, 1.177242957e-03f, 1.094888896e-03f, 1.018295996e-03f, 9.470609948e-04f, 8.808093844e-04f, 8.191923262e-04f, 7.618857198e-04f, 7.085879333e-04f, 6.590186385e-04f, 6.129170069e-04f, 5.700403708e-04f, 5.301629426e-04f, 4.930753494e-04f, 4.585822753e-04f, 4.265021416e-04f, 3.966661752e-04f, 3.689173318e-04f, 3.431097430e-04f, 3.191074939e-04f, 2.967843320e-04f, 2.760227653e-04f, 2.567135962e-04f, 2.387551940e-04f, 2.220530587e-04f, 2.065193403e-04f, 1.920722716e-04f, 1.786358480e-04f, 1.661392889e-04f, 1.545170089e-04f, 1.437077590e-04f, 1.336546848e-04f, 1.243048755e-04f, 1.156091312e-04f, 1.075216787e-04f, 9.999999747e-05f};
__device__ const float INVF_A[8] = {1.000000000e+00f, 1.939227581e-01f, 3.760603070e-02f, 7.292665076e-03f, 1.414213446e-03f, 2.742481884e-04f, 5.318296462e-05f, 1.031338525e-05f};
#define LAS __attribute__((address_space(3)))
typedef unsigned short bf16_t;
typedef short bf16x8 __attribute__((ext_vector_type(8)));
typedef short s16x4 __attribute__((ext_vector_type(4)));
typedef float f32x4 __attribute__((ext_vector_type(4)));
typedef unsigned u32x4 __attribute__((ext_vector_type(4)));
typedef unsigned u32x2 __attribute__((ext_vector_type(2)));

constexpr int NB = 2, SEQ = 4096, DM = 2048, MTOK = NB * SEQ, NIN = 12800, DFF = 5632, NGU = 2 * DFF;
constexpr int C_RQ = 0, C_RK = 1024, C_RV = 2048, C_RG = 4096, C_AQ = 6144, C_AK = 8192, C_AV = 8448, C_GA = 8704, C_GB = 10752;
constexpr float ALPHA = 1.189207115002721f, LN_EPS = 1e-5f, GN_EPS = 1e-5f;
constexpr int NWAVES = 8, NTHR = 512;
constexpr int LDS_BYTES = 147456;
constexpr size_t MiB = 1u << 20;
constexpr size_t WS_WOUT = 1 * MiB, WS_WGU = 9 * MiB, WS_WDN = 53 * MiB, WS_TABR = 75 * MiB, WS_TABA = 83 * MiB;
constexpr size_t WS_WIN = 84 * MiB, WS_XB = 134 * MiB;
constexpr size_t WS_ATT = 84 * MiB, WS_PREVT = 116 * MiB;
constexpr size_t WS_PROJ = 166 * MiB;
constexpr size_t WS_MERGED = 366 * MiB, WS_END = 398 * MiB;
constexpr size_t WS_H1 = 84 * MiB, WS_H1B = 148 * MiB, WS_ACT = 180 * MiB;
static_assert(WS_WGU + (size_t)NGU * DM * 2 <= WS_WDN && WS_WDN + (size_t)DM * DFF * 2 <= WS_TABR && WS_TABR + (size_t)MTOK * 256 * 4 <= WS_TABA && WS_TABA + (size_t)MTOK * 16 * 4 <= WS_WIN, "ws map 1");
static_assert(WS_WIN + (size_t)NIN * DM * 2 <= WS_XB && WS_XB + (size_t)MTOK * DM * 2 <= WS_PROJ && WS_PROJ + (size_t)MTOK * NIN * 2 <= WS_MERGED, "ws map 2");
static_assert(WS_PREVT + (size_t)NB * 4 * 16 * 512 * 256 * 2 <= WS_PROJ && WS_ACT + (size_t)MTOK * DFF * 2 <= WS_MERGED, "ws map 3");

__device__ const float LG2G[4] = {-4.580368961312e-02f, -2.272007650008e-02f, -1.131531322783e-02f, -5.646563141142e-03f};

__device__ __forceinline__ unsigned f2bf(float f) { unsigned u = __builtin_bit_cast(unsigned, f); return (u + 0x7fffu + ((u >> 16) & 1u)) >> 16; }
__device__ __forceinline__ unsigned pk2(float lo, float hi) { return f2bf(lo) | (f2bf(hi) << 16); }
__device__ __forceinline__ float bflo(unsigned w) { return __builtin_bit_cast(float, w << 16); }
__device__ __forceinline__ float bfhi(unsigned w) { return __builtin_bit_cast(float, w & 0xffff0000u); }
typedef float f32x2_t __attribute__((ext_vector_type(2))); typedef __bf16 bf16x2_t __attribute__((ext_vector_type(2)));
__device__ __forceinline__ unsigned cvtpk(float lo, float hi) { f32x2_t v = {lo, hi}; bf16x2_t b = __builtin_convertvector(v, bf16x2_t); return __builtin_bit_cast(unsigned, b); }
__device__ __forceinline__ f32x4 mfma16(bf16x8 a, bf16x8 b, f32x4 c) { return __builtin_amdgcn_mfma_f32_16x16x32_bf16(a, b, c, 0, 0, 0); }
typedef short v4i16_t __attribute__((ext_vector_type(4)));
__device__ __forceinline__ s16x4 tr_rd(LAS const unsigned char* p) { return __builtin_bit_cast(s16x4, __builtin_amdgcn_ds_read_tr16_b64_v4i16((LAS v4i16_t*)p)); }
__device__ __forceinline__ bf16x8 cat8(s16x4 a, s16x4 b) { return (bf16x8){a[0], a[1], a[2], a[3], b[0], b[1], b[2], b[3]}; }
__device__ __forceinline__ bf16x8 pack8(f32x4 a, f32x4 b) { u32x4 w; w.x = cvtpk(a[0], a[1]); w.y = cvtpk(a[2], a[3]); w.z = cvtpk(b[0], b[1]); w.w = cvtpk(b[2], b[3]); return __builtin_bit_cast(bf16x8, w); }
__device__ __forceinline__ float wave_sum(float v) {
#pragma unroll
    for (int o = 1; o < 64; o <<= 1) v += __shfl_xor(v, o);
    return v;
}

template <int MODE> __device__ __forceinline__ int dst_row(int c) {
    if (MODE == 1) {
        if (c < 2048) { const int j = c & 255; return (c & ~255) + ((j < 128) ? 2 * j : 2 * (j - 128) + 1); }
        if (c >= C_AQ && c < C_AV) { const int j = c & 63; if (j < 16) return (c & ~63) + ((j < 8) ? 2 * j : 2 * (j - 8) + 1); }
        return c;
    }
    if (MODE == 2) return ((c >> 7) << 8) + (c & 127);
    if (MODE == 3) return ((c >> 7) << 8) + 128 + (c & 127);
    return c;
}
template <int MODE> __device__ __forceinline__ void p0_transpose_item(const float* W, int K, int N, bf16_t* WT, LAS float* scr, int item, int lane) {
    const int nblk = N / 32, kb = item / nblk, nb = item % nblk, k0 = 64 * kb, n0 = 32 * nb;
#pragma unroll 8
    for (int i = 0; i < 32; ++i) { const int kk = 2 * i + (lane >> 5); scr[kk * 33 + (lane & 31)] = W[(size_t)(k0 + kk) * N + n0 + (lane & 31)]; }
    asm volatile("s_waitcnt lgkmcnt(0)" ::: "memory");
    const int c = lane & 7;
#pragma unroll
    for (int j = 0; j < 4; ++j) { const int n = (lane >> 3) + 8 * j; const LAS float* s = scr + (8 * c) * 33 + n;
        u32x4 o; o.x = pk2(s[0 * 33], s[1 * 33]); o.y = pk2(s[2 * 33], s[3 * 33]); o.z = pk2(s[4 * 33], s[5 * 33]); o.w = pk2(s[6 * 33], s[7 * 33]);
        *(u32x4*)(WT + (size_t)dst_row<MODE>(n0 + n) * K + k0 + 8 * c) = o; }
    asm volatile("s_waitcnt lgkmcnt(0)" ::: "memory");
}

struct Args { const float* in[14]; float* out; unsigned char* ws; int ph_lo, ph_hi; };

__device__ __forceinline__ void p0_prologue(const Args& a, LAS unsigned char* lds, int gw, int NGW, int wave, int lane, int part) {
    LAS float* scr = (LAS float*)(lds + wave * 16384);
    unsigned char* ws = a.ws;
    const float* w_in = a.in[2]; const float* w_out = a.in[6]; const float* w_gate = a.in[9]; const float* w_up = a.in[10]; const float* w_down = a.in[11];
    constexpr int I_IN = (DM / 64) * (NIN / 32), I_OUT = (DM / 64) * (DM / 32), I_G = (DM / 64) * (DFF / 32), I_D = (DFF / 64) * (DM / 32);
    constexpr int NITEMS = I_IN + I_OUT + 2 * I_G + I_D;
    const int it_lo = (part == 2) ? I_IN : 0, it_hi = (part == 1) ? I_IN : NITEMS;
    for (int it = it_lo + gw; it < it_hi; it += NGW) {
        int r = it;
        if (r < I_IN) { p0_transpose_item<1>(w_in, DM, NIN, (bf16_t*)(ws + WS_WIN), scr, r, lane); continue; } r -= I_IN;
        if (r < I_OUT) { p0_transpose_item<0>(w_out, DM, DM, (bf16_t*)(ws + WS_WOUT), scr, r, lane); continue; } r -= I_OUT;
        if (r < I_G) { p0_transpose_item<2>(w_gate, DM, DFF, (bf16_t*)(ws + WS_WGU), scr, r, lane); continue; } r -= I_G;
        if (r < I_G) { p0_transpose_item<3>(w_up, DM, DFF, (bf16_t*)(ws + WS_WGU), scr, r, lane); continue; } r -= I_G;
        p0_transpose_item<0>(w_down, DFF, DM, (bf16_t*)(ws + WS_WDN), scr, r, lane);
    }
    if (part == 2) return;
    const float* x = a.in[0]; bf16_t* xb = (bf16_t*)(ws + WS_XB);
    for (int m = gw; m < MTOK; m += NGW) {
        const f32x4* xr = (const f32x4*)(x + (size_t)m * DM) + lane; u32x2* o = (u32x2*)(xb + (size_t)m * DM) + lane;
#pragma unroll
        for (int j = 0; j < 8; ++j) { const f32x4 v = xr[64 * j]; u32x2 w; w.x = pk2(v[0], v[1]); w.y = pk2(v[2], v[3]); o[64 * j] = w; }
    }
    const int* pos = (const int*)a.in[1]; float* tabR = (float*)(ws + WS_TABR); float* tabA = (float*)(ws + WS_TABA);
    const int gt = gw * 64 + lane, NGT = NGW * 64;
    for (int i = gt; i < MTOK * 136; i += NGT) {
        const int row = i / 136, j = i % 136; const double p = (double)pos[row];
        const double fr = (j < 128) ? (double)INVF_R[j] : (double)INVF_A[j - 128];
        double t = p * fr * 0.15915494309189535; t -= __builtin_rint(t);
        const float tf = (float)t; const float cs = __builtin_amdgcn_cosf(tf), sn = __builtin_amdgcn_sinf(tf);
        if (j < 128) { tabR[(size_t)row * 256 + j] = cs; tabR[(size_t)row * 256 + 128 + j] = sn; }
        else { tabA[(size_t)row * 16 + (j - 128)] = cs; tabA[(size_t)row * 16 + 8 + (j - 128)] = sn; }
    }
}

constexpr int SC_KP = 544, SC_VP = 160, SC_VOFF = 128 * SC_KP;
__device__ __forceinline__ void scan_item(LAS unsigned char* lds, const bf16_t* proj, bf16_t* prevT, int item) {
    const int tid = threadIdx.x, lane = tid & 63, w = __builtin_amdgcn_readfirstlane(tid >> 6), fr = lane & 15, fq = lane >> 4, q4 = (lane & 15) >> 2, p4 = lane & 3;
    const int es = item & 7, h = (item >> 3) & 3, b = item >> 5;
    const float lg = LG2G[h];
    f32x4 acc[2][4];
#pragma unroll
    for (int i = 0; i < 2; ++i)
#pragma unroll
        for (int j = 0; j < 4; ++j) acc[i][j] = (f32x4){0.f, 0.f, 0.f, 0.f};
    const bf16_t* kbase = proj + (size_t)(b * SEQ) * NIN + C_RK + 256 * h;
    const bf16_t* vbase = proj + (size_t)(b * SEQ) * NIN + C_RV + 512 * h + 64 * es;
    u32x4 kr[8], vr[2];
#define SC_LOAD(step) do { const int row0_ = (step) * 128; \
    _Pragma("unroll") for (int j = 0; j < 8; ++j) { const int p = tid + 512 * j; kr[j] = *(const u32x4*)(kbase + (size_t)(row0_ + (p >> 5)) * NIN + (p & 31) * 8); } \
    _Pragma("unroll") for (int j = 0; j < 2; ++j) { const int p = tid + 512 * j; vr[j] = *(const u32x4*)(vbase + (size_t)(row0_ + (p >> 3)) * NIN + (p & 7) * 8); } } while (0)
    SC_LOAD(0);
    for (int step = 0; step < 30; ++step) {
        __syncthreads();
#pragma unroll
        for (int j = 0; j < 8; ++j) { const int p = tid + 512 * j; *(LAS u32x4*)(lds + (p >> 5) * SC_KP + (p & 31) * 16) = kr[j]; }
#pragma unroll
        for (int j = 0; j < 2; ++j) { const int p = tid + 512 * j; const int r = p >> 3; const float dc = __builtin_amdgcn_exp2f(lg * (float)(255 - ((step & 1) * 128 + r)));
            u32x4 v = vr[j], o;
            o.x = cvtpk(bflo(v.x) * dc, bfhi(v.x) * dc); o.y = cvtpk(bflo(v.y) * dc, bfhi(v.y) * dc);
            o.z = cvtpk(bflo(v.z) * dc, bfhi(v.z) * dc); o.w = cvtpk(bflo(v.w) * dc, bfhi(v.w) * dc);
            *(LAS u32x4*)(lds + SC_VOFF + r * SC_VP + (p & 7) * 16) = o; }
        __syncthreads();
        if (step + 1 < 30) SC_LOAD(step + 1);
        if ((step & 1) == 0 && step > 0) { const float cd = __builtin_amdgcn_exp2f(lg * 256.0f);
#pragma unroll
            for (int i = 0; i < 2; ++i)
#pragma unroll
                for (int j = 0; j < 4; ++j) acc[i][j] = acc[i][j] * cd; }
#pragma unroll
        for (int ks = 0; ks < 4; ++ks) {
            const int rbase = 32 * ks + 8 * fq + q4;
            bf16x8 af[2], bfr[4];
#pragma unroll
            for (int dt = 0; dt < 2; ++dt) { const LAS unsigned char* p = lds + rbase * SC_KP + (32 * w + 16 * dt + 4 * p4) * 2; af[dt] = cat8(tr_rd(p), tr_rd(p + 4 * SC_KP)); }
#pragma unroll
            for (int et = 0; et < 4; ++et) { const LAS unsigned char* p = lds + SC_VOFF + rbase * SC_VP + (16 * et + 4 * p4) * 2; bfr[et] = cat8(tr_rd(p), tr_rd(p + 4 * SC_VP)); }
#pragma unroll
            for (int dt = 0; dt < 2; ++dt)
#pragma unroll
                for (int et = 0; et < 4; ++et) acc[dt][et] = mfma16(af[dt], bfr[et], acc[dt][et]);
        }
        if (step & 1) { const int n1 = (step >> 1) + 1;
            bf16_t* ob = prevT + ((size_t)((b * 4 + h) * 16 + n1) * 512 + 64 * es) * 256;
#pragma unroll
            for (int dt = 0; dt < 2; ++dt)
#pragma unroll
                for (int et = 0; et < 4; ++et) { u32x2 o; o.x = cvtpk(acc[dt][et][0], acc[dt][et][1]); o.y = cvtpk(acc[dt][et][2], acc[dt][et][3]);
                    *(u32x2*)(ob + (size_t)(16 * et + fr) * 256 + 32 * w + 16 * dt + 4 * fq) = o; } }
    }
#undef SC_LOAD
    __syncthreads();
}

constexpr int AT_KP = 144, AT_VP = 160, AT_VOFF = 256 * AT_KP;
__device__ __forceinline__ void attn_item(LAS unsigned char* lds, const bf16_t* proj, const float* sinks, bf16_t* att, int item) {
    const int tid = threadIdx.x, lane = tid & 63, w = __builtin_amdgcn_readfirstlane(tid >> 6), fr = lane & 15, fq = lane >> 4, q4 = (lane & 15) >> 2, p4 = lane & 3;
    const int n = item & 31, kvh = (item >> 5) & 3, b = item >> 7;
    __syncthreads();
    {
        const long tok0 = (long)b * SEQ + 128 * (n - 1);
#pragma unroll
        for (int j = 0; j < 4; ++j) { const int p = tid + 512 * j, r = p >> 3, ch = p & 7;
            u32x4 kv = (u32x4){0u, 0u, 0u, 0u}, vv = (u32x4){0u, 0u, 0u, 0u};
            if (n > 0 || r >= 128) { const bf16_t* src = proj + (size_t)(tok0 + r) * NIN; kv = *(const u32x4*)(src + C_AK + 64 * kvh + ch * 8); vv = *(const u32x4*)(src + C_AV + 64 * kvh + ch * 8); }
            *(LAS u32x4*)(lds + r * AT_KP + ch * 16) = kv; *(LAS u32x4*)(lds + AT_VOFF + r * AT_VP + ch * 16) = vv; }
        if (tid < 160) *(LAS u32x4*)(lds + AT_VOFF + 256 * AT_VP + tid * 16) = (u32x4){0u, 0u, 0u, 0u};
    }
    __syncthreads();
    const int head = 8 * kvh + w;
    const float sink2 = sinks[head] * 1.4426950408889634f;
    for (int sb = 0; sb < 8; ++sb) {
        const size_t tok = (size_t)b * SEQ + 128 * n + 16 * sb + fr;
        bf16x8 qf[2];
#pragma unroll
        for (int s = 0; s < 2; ++s) qf[s] = *(const bf16x8*)(proj + tok * NIN + C_AQ + 64 * head + 32 * s + 8 * fq);
        f32x4 st[9];
#pragma unroll
        for (int t = 0; t < 9; ++t) { st[t] = (f32x4){0.f, 0.f, 0.f, 0.f};
#pragma unroll
            for (int s = 0; s < 2; ++s) { const bf16x8 kf = *(const LAS bf16x8*)(lds + (16 * (sb + t) + fr) * AT_KP + (32 * s + 8 * fq) * 2); st[t] = mfma16(kf, qf[s], st[t]); } }
        const int qi = 16 * sb + fr; float mx = -INFINITY;
#pragma unroll
        for (int t = 0; t < 9; ++t)
#pragma unroll
            for (int i = 0; i < 4; ++i) { const int kj = 16 * (sb + t) + 4 * fq + i, dist = 128 + qi - kj; const bool ok = (dist >= 0) && (dist < 128) && (n > 0 || kj >= 128);
                const float v = ok ? st[t][i] : -INFINITY; st[t][i] = v; mx = fmaxf(mx, v); }
        mx = fmaxf(mx, __shfl_xor(mx, 16)); mx = fmaxf(mx, __shfl_xor(mx, 32)); mx = fmaxf(mx, sink2);
        float sum = 0.f;
#pragma unroll
        for (int t = 0; t < 9; ++t)
#pragma unroll
            for (int i = 0; i < 4; ++i) { const float p = __builtin_amdgcn_exp2f(st[t][i] - mx); st[t][i] = p; sum += p; }
        sum += __shfl_xor(sum, 16); sum += __shfl_xor(sum, 32);
        const float rden = 1.0f / (sum + __builtin_amdgcn_exp2f(sink2 - mx));
        f32x4 o[4];
#pragma unroll
        for (int dt = 0; dt < 4; ++dt) o[dt] = (f32x4){0.f, 0.f, 0.f, 0.f};
#pragma unroll
        for (int ks = 0; ks < 5; ++ks) {
            const bf16x8 pf = pack8(st[2 * ks], (2 * ks + 1 < 9) ? st[(2 * ks + 1 < 9) ? 2 * ks + 1 : 8] : (f32x4){0.f, 0.f, 0.f, 0.f});
            const LAS unsigned char* vb = lds + AT_VOFF + (16 * (sb + 2 * ks) + 4 * fq + q4) * AT_VP + (4 * p4) * 2;
#pragma unroll
            for (int dt = 0; dt < 4; ++dt) { const bf16x8 vf = cat8(tr_rd(vb + dt * 32), tr_rd(vb + 16 * AT_VP + dt * 32)); o[dt] = mfma16(vf, pf, o[dt]); }
        }
        bf16_t* op = att + tok * DM + 64 * head + 4 * fq;
#pragma unroll
        for (int dt = 0; dt < 4; ++dt) { u32x2 ov; ov.x = cvtpk(o[dt][0] * rden, o[dt][1] * rden); ov.y = cvtpk(o[dt][2] * rden, o[dt][3] * rden); *(u32x2*)(op + 16 * dt) = ov; }
    }
}

constexpr int R3_P = 528, R3_VP = 1056, R3_VOFF = 32 * R3_P, R3_BUF = R3_VOFF + 32 * R3_VP;
static_assert(R3_BUF >= 64 * R3_P && 2 * R3_BUF <= 131072, "P3 LDS");
__device__ __forceinline__ void ret_item(LAS unsigned char* lds, const bf16_t* proj, const bf16_t* prevT, const bf16_t* att, const float* gn_g, const float* gn_b, bf16_t* merged, int item) {
    const int tid = threadIdx.x, lane = tid & 63, w = __builtin_amdgcn_readfirstlane(tid >> 6), fr = lane & 15, fq = lane >> 4, q4 = (lane & 15) >> 2, p4 = lane & 3;
    const int half = item & 1, n = (item >> 1) & 15, h = (item >> 5) & 3, b = item >> 7;
    const float lg = LG2G[h];
    const int c0 = 128 * half + 16 * w;
    const size_t tokc = (size_t)b * SEQ + 256 * n;
    bf16x8 qf[8];
#pragma unroll
    for (int s = 0; s < 8; ++s) qf[s] = *(const bf16x8*)(proj + (tokc + c0) * NIN + C_RQ + 256 * h + (unsigned)(fr * NIN + 32 * s + 8 * fq));
    f32x4 acc[32];
#pragma unroll
    for (int i = 0; i < 32; ++i) acc[i] = (f32x4){0.f, 0.f, 0.f, 0.f};
    u32x4 pr[6];
    const bf16_t* pT = prevT + (size_t)((b * 4 + h) * 16 + n) * 512 * 256;
    const bf16_t* kg = proj + tokc * NIN + C_RK + 256 * h;
    const bf16_t* vg = proj + tokc * NIN + C_RV + 512 * h;
#define R3_LOAD1(eb) do { int tq_ = tid; asm volatile("" : "+v"(tq_)); const bf16_t* b_ = pT + (size_t)(64 * (eb)) * 256; _Pragma("unroll") for (int j = 0; j < 4; ++j) { const int p = tq_ + 512 * j; pr[j] = *(const u32x4*)(b_ + (unsigned)((p >> 5) * 256 + (p & 31) * 8)); } } while (0)
#define R3_STORE1(buf) do { int tq_ = tid; asm volatile("" : "+v"(tq_)); _Pragma("unroll") for (int j = 0; j < 4; ++j) { const int p = tq_ + 512 * j; *(LAS u32x4*)((buf) + (p >> 5) * R3_P + (p & 31) * 16) = pr[j]; } } while (0)
#define R3_LOAD2(kb) do { int tq_ = tid; asm volatile("" : "+v"(tq_)); const bf16_t* kb_ = kg + (size_t)(32 * (kb)) * NIN; const bf16_t* vb_ = vg + (size_t)(32 * (kb)) * NIN; _Pragma("unroll") for (int j = 0; j < 2; ++j) { const int p = tq_ + 512 * j; pr[j] = *(const u32x4*)(kb_ + (unsigned)((p >> 5) * NIN + (p & 31) * 8)); } \
    _Pragma("unroll") for (int j = 0; j < 4; ++j) { const int p = tq_ + 512 * j; pr[2 + j] = *(const u32x4*)(vb_ + (unsigned)((p >> 6) * NIN + (p & 63) * 8)); } } while (0)
#define R3_STORE2(buf) do { int tq_ = tid; asm volatile("" : "+v"(tq_)); _Pragma("unroll") for (int j = 0; j < 2; ++j) { const int p = tq_ + 512 * j; *(LAS u32x4*)((buf) + (p >> 5) * R3_P + (p & 31) * 16) = pr[j]; } \
    _Pragma("unroll") for (int j = 0; j < 4; ++j) { const int p = tq_ + 512 * j; *(LAS u32x4*)((buf) + R3_VOFF + (p >> 6) * R3_VP + (p & 63) * 16) = pr[2 + j]; } } while (0)
    __syncthreads();
    if (n > 0) { R3_LOAD1(0); R3_STORE1(lds); } else { R3_LOAD2(0); R3_STORE2(lds); }
    __syncthreads();
    if (n > 0) {
#pragma unroll
        for (int eb = 0; eb < 8; ++eb) {
            LAS unsigned char* cur = lds + (eb & 1) * R3_BUF; LAS unsigned char* nxt = lds + ((eb + 1) & 1) * R3_BUF;
            if (eb < 7) R3_LOAD1(eb + 1); else R3_LOAD2(0);
#pragma unroll
            for (int et = 0; et < 4; ++et)
#pragma unroll
                for (int s = 0; s < 8; ++s) { const bf16x8 af = *(const LAS bf16x8*)(cur + (16 * et + fr) * R3_P + (32 * s + 8 * fq) * 2); acc[4 * eb + et] = mfma16(af, qf[s], acc[4 * eb + et]); if (s == 7) __builtin_amdgcn_sched_barrier(0); }
            if (eb < 7) R3_STORE1(nxt); else R3_STORE2(nxt);
            __syncthreads();
        }
        const float qd = __builtin_amdgcn_exp2f(lg * (float)(c0 + fr + 1));
#pragma unroll
        for (int i = 0; i < 32; ++i) acc[i] = acc[i] * qd;
    }
    const int nkb = 4 * (half + 1);
    for (int kb = 0; kb < nkb; ++kb) {
        LAS unsigned char* cur = lds + (kb & 1) * R3_BUF; LAS unsigned char* nxt = lds + ((kb + 1) & 1) * R3_BUF;
        if (kb + 1 < nkb) R3_LOAD2(kb + 1);
        if (32 * kb <= c0 + 15) {
            f32x4 st[2];
#pragma unroll
            for (int t = 0; t < 2; ++t) { st[t] = (f32x4){0.f, 0.f, 0.f, 0.f};
#pragma unroll
                for (int s = 0; s < 8; ++s) { const bf16x8 kf = *(const LAS bf16x8*)(cur + (16 * t + fr) * R3_P + (32 * s + 8 * fq) * 2); st[t] = mfma16(kf, qf[s], st[t]); } }
            const int c = c0 + fr;
#pragma unroll
            for (int t = 0; t < 2; ++t)
#pragma unroll
                for (int i = 0; i < 4; ++i) { const int dlt = c - (32 * kb + 16 * t + 4 * fq + i); st[t][i] = (dlt >= 0) ? st[t][i] * __builtin_amdgcn_exp2f(lg * (float)dlt) : 0.f; }
            const bf16x8 pf = pack8(st[0], st[1]);
            const LAS unsigned char* vb = cur + R3_VOFF + (4 * fq + q4) * R3_VP + (4 * p4) * 2;
#pragma unroll
            for (int et = 0; et < 32; ++et) { const bf16x8 vf = cat8(tr_rd(vb + et * 32), tr_rd(vb + 16 * R3_VP + et * 32)); acc[et] = mfma16(vf, pf, acc[et]); if ((et & 3) == 3) __builtin_amdgcn_sched_barrier(0); }
        }
        if (kb + 1 < nkb) R3_STORE2(nxt);
        __syncthreads();
    }
#undef R3_LOAD1
#undef R3_STORE1
#undef R3_LOAD2
#undef R3_STORE2
    float s1 = 0.f;
#pragma unroll
    for (int i = 0; i < 32; ++i) s1 += (acc[i][0] + acc[i][1]) + (acc[i][2] + acc[i][3]);
    s1 += __shfl_xor(s1, 16); s1 += __shfl_xor(s1, 32);
    const float mu = s1 * (1.0f / 512.0f); float s2 = 0.f;
#pragma unroll
    for (int i = 0; i < 32; ++i) { const f32x4 d = acc[i] - mu; s2 += (d[0] * d[0] + d[1] * d[1]) + (d[2] * d[2] + d[3] * d[3]); }
    s2 += __shfl_xor(s2, 16); s2 += __shfl_xor(s2, 32);
    const float rstd = 1.0f / sqrtf(s2 * (1.0f / 512.0f) + GN_EPS);
    const bf16_t* prow0 = proj + (tokc + c0) * NIN; const bf16_t* arow0 = att + (tokc + c0) * DM; bf16_t* mrow0 = merged + (tokc + c0) * DM;
#pragma unroll
    for (int et = 0; et < 32; ++et) { const int col = 512 * h + 16 * et + 4 * fq;
        const f32x4 gg = *(const f32x4*)(gn_g + col), gb = *(const f32x4*)(gn_b + col);
        const unsigned po = (unsigned)(fr * NIN + col), ao = (unsigned)(fr * DM + col);
        const u32x2 sg = *(const u32x2*)(prow0 + C_RG + po), ga = *(const u32x2*)(prow0 + C_GA + po), gbb = *(const u32x2*)(prow0 + C_GB + po), av = *(const u32x2*)(arow0 + ao);
        const f32x4 y = (acc[et] - mu) * rstd * gg + gb;
        const float r0 = bflo(ga.x) * (bflo(sg.x) * y[0]) + bflo(gbb.x) * bflo(av.x), r1 = bfhi(ga.x) * (bfhi(sg.x) * y[1]) + bfhi(gbb.x) * bfhi(av.x);
        const float r2 = bflo(ga.y) * (bflo(sg.y) * y[2]) + bflo(gbb.y) * bflo(av.y), r3 = bfhi(ga.y) * (bfhi(sg.y) * y[3]) + bfhi(gbb.y) * bfhi(av.y);
        u32x2 o; o.x = cvtpk(r0, r1); o.y = cvtpk(r2, r3); *(u32x2*)(mrow0 + ao) = o; if (et & 1) __builtin_amdgcn_sched_barrier(0); }
}

template <bool WB> __device__ __forceinline__ void ln_rows(const float* z, const float* g, const float* bta, float* outf, bf16_t* outb, int gw, int NGW, int lane) {
    for (int m = gw; m < MTOK; m += NGW) {
        const f32x4* zr = (const f32x4*)(z + (size_t)m * DM) + lane; f32x4 v[8]; float s = 0.f;
#pragma unroll
        for (int j = 0; j < 8; ++j) { v[j] = zr[64 * j]; s += (v[j][0] + v[j][1]) + (v[j][2] + v[j][3]); }
        const float mean = wave_sum(s) * (1.0f / DM); float s2 = 0.f;
#pragma unroll
        for (int j = 0; j < 8; ++j) { v[j] = v[j] - mean; s2 += (v[j][0] * v[j][0] + v[j][1] * v[j][1]) + (v[j][2] * v[j][2] + v[j][3] * v[j][3]); }
        const float rstd = 1.0f / sqrtf(wave_sum(s2) * (1.0f / DM) + LN_EPS);
        f32x4* of = (f32x4*)(outf + (size_t)m * DM) + lane; u32x2* ob = (u32x2*)(outb + (size_t)m * DM) + lane;
#pragma unroll
        for (int j = 0; j < 8; ++j) { const f32x4 gg = ((const f32x4*)g)[lane + 64 * j], bb = ((const f32x4*)bta)[lane + 64 * j]; const f32x4 y = v[j] * rstd * gg + bb; of[64 * j] = y;
            if (WB) { u32x2 w; w.x = pk2(y[0], y[1]); w.y = pk2(y[2], y[3]); ob[64 * j] = w; } }
    }
}

#define XB_TMO      128
#define XB_XCNT(j)  (256  + 64 * (j))
#define XB_XSUB(j)  (1280 + 64 * (j))
#define XB_XGEN(j)  (2304 + 64 * (j))
#define XB_TOP      3328
#define XB_TOPGEN   3392
#define XCD_BAR_WORDS 3456
#define XB_SPIN_CAP (1u << 18)

__device__ __forceinline__ unsigned xb_ld(unsigned* p)              { return __hip_atomic_load(p, __ATOMIC_RELAXED, __HIP_MEMORY_SCOPE_AGENT); }
__device__ __forceinline__ unsigned xb_add(unsigned* p, unsigned v) { return __hip_atomic_fetch_add(p, v, __ATOMIC_RELAXED, __HIP_MEMORY_SCOPE_AGENT); }
__device__ __forceinline__ unsigned xb_xcc_id() { return (unsigned)__builtin_amdgcn_s_getreg((3 << 11) | 20) & 0xFu; }
#define XB_SPIN(cond, bar) do { unsigned _sp = 0; while (cond) { __builtin_amdgcn_s_sleep(1); \
    if ((++_sp & 255u) == 0u) { if (xb_ld(&(bar)[XB_TMO])) break; if (_sp > XB_SPIN_CAP) { atomicAdd(&(bar)[XB_TMO], 1u); break; } } } } while (0)

struct XcdBarrier {
    unsigned* bar; unsigned x;
    volatile LAS unsigned* st;
};

__device__ __forceinline__ XcdBarrier xcd_barrier_post(unsigned* bar, volatile LAS unsigned* st) {
    XcdBarrier b; b.bar = bar; b.x = xb_xcc_id(); b.st = st;
    if (threadIdx.x == 0) (void)xb_add(&bar[XB_XCNT(b.x)], 1u);
    return b;
}
__device__ __forceinline__ void xcd_barrier_complete(unsigned* bar, unsigned x, unsigned& nloc, unsigned& nx) {
    const unsigned G = gridDim.x * gridDim.y * gridDim.z;
    unsigned sum, cnt, mine, sp = 0u;
    for (;;) {
        sum = 0u; cnt = 0u; mine = 0u;
#pragma unroll
        for (unsigned j = 0; j < 16; ++j) { const unsigned c = xb_ld(&bar[XB_XCNT(j)]); sum += c; cnt += (c > 0u) ? 1u : 0u; mine = (j == x) ? c : mine; }
        if (sum == G) break;
        __builtin_amdgcn_s_sleep(1);
        if ((++sp & 255u) == 0u) { if (xb_ld(&bar[XB_TMO])) break; if (sp > XB_SPIN_CAP) { atomicAdd(&bar[XB_TMO], 1u); break; } }
    }
    nloc = mine > 0u ? mine : 1u; nx = cnt > 0u ? cnt : 1u;
}

__device__ __forceinline__ void xcd_barrier(const XcdBarrier& b) {
    asm volatile("s_waitcnt vmcnt(0)" ::: "memory");
    __syncthreads();
    if (threadIdx.x == 0) {
        unsigned* bar = b.bar;
        __builtin_amdgcn_s_waitcnt(0);
        unsigned nloc = b.st[0], nx = b.st[1];
        if (nloc == 0u) { xcd_barrier_complete(bar, b.x, nloc, nx); b.st[0] = nloc; b.st[1] = nx; }
        const unsigned old = xb_add(&bar[XB_XSUB(b.x)], 1u);
        const unsigned gen = old / nloc;
        if (old + 1u == (gen + 1u) * nloc) {
            __builtin_amdgcn_fence(__ATOMIC_RELEASE, "agent");
            asm volatile("s_waitcnt vmcnt(0)" ::: "memory");
            const unsigned og = xb_add(&bar[XB_TOP], 1u);
            const unsigned tg = og / nx;
            if (og + 1u == (tg + 1u) * nx) xb_add(&bar[XB_TOPGEN], 1u);
            else XB_SPIN(xb_ld(&bar[XB_TOPGEN]) == tg, bar);
            __builtin_amdgcn_fence(__ATOMIC_ACQUIRE, "agent");
            xb_add(&bar[XB_XGEN(b.x)], 1u);
            asm volatile("s_waitcnt vmcnt(0)" ::: "memory");
        } else {
            XB_SPIN(xb_ld(&bar[XB_XGEN(b.x)]) == gen, bar);
            __builtin_amdgcn_fence(__ATOMIC_ACQUIRE, "agent");
            asm volatile("s_waitcnt vmcnt(0)" ::: "memory");
        }
    }
    __syncthreads();
}

#ifndef MK_PER_PHASE
#define MK_PER_PHASE 0
#endif
constexpr int N_PHASES = 9;
__global__ void __launch_bounds__(NTHR, 2) hybrid_fwd(Args args) {
    extern __shared__ __attribute__((aligned(16))) unsigned char lds_raw[];
    LAS unsigned char* lds = (LAS unsigned char*)lds_raw;
    const int tid = threadIdx.x, lane = tid & 63, wave = __builtin_amdgcn_readfirstlane(tid >> 6);
    const int G = gridDim.x, bx = blockIdx.x;
    const int gw = bx * NWAVES + wave, NGW = G * NWAVES;
    unsigned char* ws = args.ws;
    bf16_t* proj = (bf16_t*)(ws + WS_PROJ); bf16_t* attb = (bf16_t*)args.out; bf16_t* prevT = (bf16_t*)((unsigned char*)args.out + 32 * MiB); bf16_t* merged = (bf16_t*)(ws + WS_MERGED);
    float* zbuf = args.out; float* h1 = (float*)(ws + WS_H1); bf16_t* h1b = (bf16_t*)(ws + WS_H1B); bf16_t* actb = (bf16_t*)(ws + WS_ACT);
    const int lo = args.ph_lo, hi = args.ph_hi;
    volatile LAS unsigned* misc = (volatile LAS unsigned*)(lds + 131072 + 8192);
    unsigned* ctl = (unsigned*)ws;
    int vcu = bx;
#ifndef DUP_PHASE
#define DUP_PHASE -1
#endif
#ifdef PROBE_A
#define STAMP(k) do { if (tid == 0) misc[16 + (k)] = (unsigned)__builtin_amdgcn_s_memrealtime(); } while (0)
#else
#define STAMP(k) do { } while (0)
#endif
#if !MK_PER_PHASE
    if (args.ph_hi > 1000) cg::this_grid().sync();
    if (tid < 16) misc[tid] = 0u;
    __syncthreads();
    XcdBarrier xbar = xcd_barrier_post(ctl + 4096, misc + 8);
    if (tid == 0) { const unsigned x = (unsigned)__builtin_amdgcn_s_getreg((3 << 11) | 20) & 0xFu; misc[0] = x; misc[1] = __hip_atomic_fetch_add(ctl + 64 * x, 1u, __ATOMIC_RELAXED, __HIP_MEMORY_SCOPE_AGENT); }
#endif
#ifndef PH_MASK
#define PH_MASK 0x1ff
#endif
#define IN(k) ((((PH_MASK) >> (k)) & 1) && lo <= (k) && (k) < hi)
#if MK_PER_PHASE
#define GRID_BAR() do { } while (0)
#else
#define GRID_BAR() do { xcd_barrier(xbar); } while (0)
#endif
    STAMP(0);
    const bool fast = (G == 256) && !MK_PER_PHASE;
    if (IN(0)) { p0_prologue(args, lds, gw, NGW, wave, lane, fast ? 1 : 0); if (IN(1)) GRID_BAR(); }
    STAMP(1);
#if !MK_PER_PHASE
    if (tid == 0) { bool even = (G % 8 == 0); for (int j = 0; j < 16; ++j) { const unsigned c = __hip_atomic_load(ctl + 64 * j, __ATOMIC_RELAXED, __HIP_MEMORY_SCOPE_AGENT); if (c != (j < 8 ? (unsigned)G / 8u : 0u)) even = false; }
        misc[2] = even ? misc[1] * 8u + misc[0] : (unsigned)bx; }
    __syncthreads();
    vcu = (int)misc[2];
    vcu = __builtin_amdgcn_readfirstlane(vcu);
#endif
    if (IN(1)) {
        pg8::Gemm g{(const bf16_t*)(ws + WS_XB), (const bf16_t*)(ws + WS_WIN), MTOK, NIN, DM}; pg8::RoundRange S; S.S.init(MTOK, NIN, G, vcu); S.i0 = 0; S.i1 = fast ? 6 : (1 << 20); S.swap = fast;
        pg8::EpiInProj E{proj, (const float*)(ws + WS_TABR), (const float*)(ws + WS_TABA)};
        pg8::gemm_phase<pg8::EpiInProj, pg8::RoundRange, true, true>(lds, g, S, E);
        if (IN(2)) GRID_BAR();
        STAMP(2);
    }
    if (IN(2)) {
        if (!fast) { for (int it = vcu; it < 64 + 256; it += G) { if (it < 64) scan_item(lds, proj, prevT, it); else attn_item(lds, proj, args.in[5], attb, it - 64); } }
        else {
            if (vcu < 64) scan_item(lds, proj, prevT, vcu);
            else if (vcu < 128) {
                pg8::Gemm g{(const bf16_t*)(ws + WS_XB), (const bf16_t*)(ws + WS_WIN), MTOK, NIN, DM}; pg8::RoundRange S; S.S.init(MTOK, NIN, G, vcu - 64); S.i0 = 6; S.i1 = 7; S.swap = true;
                pg8::EpiInProj E{proj, (const float*)(ws + WS_TABR), (const float*)(ws + WS_TABA)};
                pg8::gemm_phase<pg8::EpiInProj, pg8::RoundRange, true, true>(lds, g, S, E);
            } else { p0_prologue(args, lds, (vcu - 128) * NWAVES + wave, 128 * NWAVES, wave, lane, 2); }
            if (vcu >= 64) attn_item(lds, proj, args.in[5], attb, vcu - 64);
            if (vcu >= 192) attn_item(lds, proj, args.in[5], attb, vcu);
        }
        if (IN(3)) GRID_BAR();
        STAMP(3);
    }
    if (IN(3)) {
        for (int rep = 0; rep < (DUP_PHASE == 3 ? 2 : 1); ++rep) { if (rep) GRID_BAR();
            for (int it = vcu; it < 256; it += G) ret_item(lds, proj, prevT, attb, args.in[3], args.in[4], merged, it);
        }
        __syncthreads();
        if (IN(4)) GRID_BAR();
        STAMP(4);
    }
    if (IN(4)) {
        pg8::Gemm g{merged, (const bf16_t*)(ws + WS_WOUT), MTOK, DM, DM}; pg8::StaticOrder S; S.init(MTOK, DM, G, vcu);
        pg8::EpiResF32 E{args.in[0], zbuf, DM, ALPHA};
        pg8::gemm_phase<pg8::EpiResF32, pg8::StaticOrder, true, true>(lds, g, S, E);
        if (IN(5)) GRID_BAR();
        STAMP(5);
    }
    if (IN(5)) { ln_rows<true>(zbuf, args.in[7], args.in[8], h1, h1b, gw, NGW, lane); if (IN(6)) GRID_BAR(); }
    STAMP(6);
    if (IN(6)) {
        pg8::Gemm g{h1b, (const bf16_t*)(ws + WS_WGU), MTOK, NGU, DM}; pg8::StaticOrder S; S.init(MTOK, NGU, G, vcu);
        pg8::EpiSwiGLU E{actb, DFF};
        pg8::gemm_phase<pg8::EpiSwiGLU, pg8::StaticOrder, true, true>(lds, g, S, E);
        if (IN(7)) GRID_BAR();
        STAMP(7);
    }
    if (IN(7)) {
        pg8::Gemm g{actb, (const bf16_t*)(ws + WS_WDN), MTOK, DM, DFF}; pg8::StaticOrder S; S.init(MTOK, DM, G, vcu);
        pg8::EpiResF32 E{h1, zbuf, DM, ALPHA};
        pg8::gemm_phase<pg8::EpiResF32, pg8::StaticOrder, true, true>(lds, g, S, E);
        if (IN(8)) GRID_BAR();
        STAMP(8);
    }
    if (IN(8)) { ln_rows<false>(zbuf, args.in[12], args.in[13], args.out, nullptr, gw, NGW, lane); }
#ifdef PROBE_A
    GRID_BAR(); STAMP(9);
    if (bx == 0) { __syncthreads();
        const float da = (float)(misc[16 + PROBE_A + 1] - misc[16 + PROBE_A]) * 0.01f, db = (float)(misc[16 + PROBE_B + 1] - misc[16 + PROBE_B]) * 0.01f;
        if (tid == 0) args.out[0] += da;
        for (int i = tid; i < 65536; i += NTHR) args.out[2048 + i] += db * (1.0f / 64.0f); }
#endif
#undef IN
#undef GRID_BAR
}

#ifndef DBG_STOP
#define DBG_STOP 0
#endif
__global__ void dbg_dump(const unsigned short* src, int pitch, float* out) {
    const size_t i = (size_t)blockIdx.x * blockDim.x + threadIdx.x;
    const size_t r = i / DM, c = i % DM;
    float acc = 0.f;
    for (size_t cc = c; cc < (size_t)pitch; cc += DM) acc += __builtin_bit_cast(float, (unsigned)src[r * pitch + cc] << 16);
    out[i] = acc;
}
extern "C" void kernel_launch(void* const* d_in, const int* in_sizes, int n_in, void* d_out, int out_size, void* d_ws, size_t ws_size, hipStream_t stream) {
    static int grid = 0;
    if (grid == 0) {
        if (n_in != 14 || in_sizes[0] != MTOK * DM || out_size != MTOK * DM || ws_size < WS_END) { fprintf(stderr, "kernel_launch: unexpected shapes / workspace (n_in %d, ws %zu, need %zu)\n", n_in, ws_size, (size_t)WS_END); grid = -1; return; }
        int dev = 0, cus = 0, per_cu = 0;
        if (hipGetDevice(&dev) != hipSuccess || hipDeviceGetAttribute(&cus, hipDeviceAttributeMultiprocessorCount, dev) != hipSuccess) { grid = -1; return; }
        if (hipFuncSetAttribute((const void*)hybrid_fwd, hipFuncAttributeMaxDynamicSharedMemorySize, LDS_BYTES) != hipSuccess) { fprintf(stderr, "kernel_launch: hipFuncSetAttribute failed\n"); grid = -1; return; }
        if (hipOccupancyMaxActiveBlocksPerMultiprocessor(&per_cu, (const void*)hybrid_fwd, NTHR, LDS_BYTES) != hipSuccess || per_cu < 1) { fprintf(stderr, "kernel_launch: occupancy query gave %d\n", per_cu); per_cu = 1; }
        (void)hipGetLastError();
        grid = cus * per_cu;
    }
    if (grid < 0) return;
    Args a{};
    for (int i = 0; i < 14; ++i) a.in[i] = (const float*)d_in[i];
    a.out = (float*)d_out; a.ws = (unsigned char*)d_ws;
#if MK_PER_PHASE
    const int np_ = DBG_STOP ? DBG_STOP + 1 : N_PHASES;
    for (int p = 0; p < np_; ++p) { a.ph_lo = p; a.ph_hi = p + 1; hipLaunchKernelGGL(hybrid_fwd, dim3(grid), dim3(NTHR), LDS_BYTES, stream, a); }
    if (DBG_STOP == 1) hipLaunchKernelGGL(dbg_dump, dim3(MTOK * DM / 256), dim3(256), 0, stream, (const unsigned short*)((unsigned char*)d_ws + WS_PROJ), NIN, (float*)d_out);
    if (DBG_STOP == 2) hipLaunchKernelGGL(dbg_dump, dim3(MTOK * DM / 256), dim3(256), 0, stream, (const unsigned short*)((unsigned char*)d_ws + WS_PREVT), DM, (float*)d_out);
    if (DBG_STOP == 3) hipLaunchKernelGGL(dbg_dump, dim3(MTOK * DM / 256), dim3(256), 0, stream, (const unsigned short*)((unsigned char*)d_ws + WS_MERGED), DM, (float*)d_out);
    if (DBG_STOP == 6) hipLaunchKernelGGL(dbg_dump, dim3(MTOK * DM / 256), dim3(256), 0, stream, (const unsigned short*)((unsigned char*)d_ws + WS_ACT), DFF, (float*)d_out);
#else
    a.ph_lo = 0; a.ph_hi = N_PHASES;
    (void)hipMemsetAsync(d_ws, 0, 65536, stream);
    void* kargs[] = {&a};
    hipError_t e = hipLaunchCooperativeKernel((const void*)hybrid_fwd, dim3(grid), dim3(NTHR), kargs, LDS_BYTES, stream);
    if (e != hipSuccess) fprintf(stderr, "cooperative launch failed: %s (grid %d)\n", hipGetErrorString(e), grid);
#endif
}
```

```cpp
#include <hip/hip_runtime.h>
#include <hip/hip_cooperative_groups.h>
#include <cstdio>
#include <cstdint>
namespace cg = cooperative_groups;
namespace pg8 {
#define PG8_LAS __attribute__((address_space(3)))
typedef unsigned short bf16_t;
typedef short bf16x8 __attribute__((ext_vector_type(8)));
typedef float f32x4 __attribute__((ext_vector_type(4)));
typedef unsigned u32x4 __attribute__((ext_vector_type(4)));
constexpr int BM = 256, BK = 64, HALF = 128, HTB = HALF * BK * 2  , STAGE_BYTES = 8 * HTB, NXCD = 8, WGM = 8;

__host__ __device__ __forceinline__ int lds_byte(int r, int c) { const int st = (r >> 4) * 2 + (c >> 5), rr = r & 15, cc = c & 31, ob = rr * 64 + cc * 2; return st * 1024 + (ob ^ (((ob >> 9) & 1) << 5)); }
__host__ __device__ __forceinline__ void stage_rc(int b, int& R, int& C) { const int st = b / 1024, sb = b % 1024, swz = sb ^ (((sb >> 9) & 1) << 5); R = (st >> 1) * 16 + swz / 64; C = (st & 1) * 32 + (swz % 64) / 2; }
__host__ __device__ __forceinline__ int perm32(int rho) { const int n = rho >> 4, i = rho & 15; return 8 * (i >> 2) + 4 * n + (i & 3); }

struct Unit { int pm, pn; };
struct Gemm { const bf16_t* A; const bf16_t* Bt; int M, N, K; };

struct StaticOrder {
    int nM, nN, nwg, G, c;
    __host__ __device__ void init(int M, int N, int G_, int c_) { nM = M / BM; nN = N / BM; nwg = nM * nN; G = G_; c = c_; }
    __host__ __device__ bool next(int i, Unit& u) const {
        const long L = (long)i * G + c; if (L >= nwg) return false;
        int wgid = (int)L; { const int q = nwg / NXCD, r = nwg % NXCD, xcd = wgid % NXCD, off = wgid / NXCD; wgid = (xcd < r ? xcd * (q + 1) : r * (q + 1) + (xcd - r) * q) + off; }
        const int nig = WGM * nN, gid = wgid / nig, fm = gid * WGM, gsz = (nM - fm) < WGM ? (nM - fm) : WGM;
        u.pm = fm + ((wgid % nig) % gsz); u.pn = (wgid % nig) / gsz; return true;
    }
    __device__ __forceinline__ void a_ready(const Unit&) const {}
    __device__ __forceinline__ void done(const Unit&) const {}
};

__device__ __forceinline__ unsigned cvt_pk_bf16(float lo, float hi) { unsigned r; asm volatile("v_cvt_pk_bf16_f32 %0, %1, %2" : "=v"(r) : "v"(lo), "v"(hi)); return r; }
typedef float f32x2 __attribute__((ext_vector_type(2)));
struct RoundRange {
    StaticOrder S; int i0, i1; bool swap;
    __device__ __forceinline__ bool next(int i, Unit& u) const { if (i0 + i >= i1) return false; if (!S.next(i0 + i, u)) return false; if (swap) u.pn = (u.pn == 24) ? 48 : (u.pn == 48) ? 24 : u.pn; return true; }
    __device__ __forceinline__ void a_ready(const Unit&) const {}
    __device__ __forceinline__ void done(const Unit&) const {}
};
__device__ __forceinline__ float sigmoidf_(float x) { return __builtin_amdgcn_rcpf(1.0f + __expf(-x)); }
struct EpiInProj {
    static constexpr bool PERM = true, AFTER_DRAIN = false;
    bf16_t* O; const float* tabR; const float* tabA;
    __device__ __forceinline__ void operator()(const f32x4 (&acc)[2][2][4][2], const Unit& u, int wr, int wc, int fr, int fq) const {
        const int pn = u.pn, ldc = 12800;
        const int row0 = u.pm * BM + wr * 64 + fr, col0 = pn * BM + wc * 32 + 8 * fq;
        int mode; float sc = 1.f;
        if (pn < 4) { mode = 1; sc = 0.0625f; } else if (pn < 8) { mode = 1; } else if (pn < 16) { mode = 0; } else if (pn < 24) { mode = 2; }
        else if (pn < 32) { mode = 3; sc = 0.18033688011112042f; } else if (pn == 32) { mode = 3; } else if (pn == 33) { mode = 0; } else { mode = 4; }
        const bool arot = (mode == 3) && ((wc & 1) == 0) && (fq < 2);
#pragma unroll
        for (int ai = 0; ai < 2; ++ai)
#pragma unroll
            for (int m = 0; m < 4; ++m) { const int row = row0 + ai * HALF + m * 16; bf16_t* rowp = O + (size_t)row * ldc + col0;
#pragma unroll
                for (int bj = 0; bj < 2; ++bj) { f32x4 v0 = acc[ai][bj][m][0], v1 = acc[ai][bj][m][1];
                    if (mode == 1 || arot) {
                        f32x4 c4, s4;
                        if (mode == 1) { const float* t = tabR + (size_t)row * 256 + 64 * bj + 16 * wc + 4 * fq; c4 = *(const f32x4*)t; s4 = *(const f32x4*)(t + 128); }
                        else { const float* t = tabA + (size_t)row * 16 + 4 * fq; c4 = *(const f32x4*)t; s4 = *(const f32x4*)(t + 8); }
                        f32x4 w0, w1;
                        w0[0] = v0[0] * c4[0] - v0[1] * s4[0]; w0[1] = v0[1] * c4[0] + v0[0] * s4[0];
                        w0[2] = v0[2] * c4[1] - v0[3] * s4[1]; w0[3] = v0[3] * c4[1] + v0[2] * s4[1];
                        w1[0] = v1[0] * c4[2] - v1[1] * s4[2]; w1[1] = v1[1] * c4[2] + v1[0] * s4[2];
                        w1[2] = v1[2] * c4[3] - v1[3] * s4[3]; w1[3] = v1[3] * c4[3] + v1[2] * s4[3];
                        v0 = w0; v1 = w1;
                    }
                    if (mode == 2) {
#pragma unroll
                        for (int i = 0; i < 4; ++i) { v0[i] = v0[i] * sigmoidf_(v0[i]); v1[i] = v1[i] * sigmoidf_(v1[i]); } }
                    if (mode == 4) {
#pragma unroll
                        for (int i = 0; i < 4; ++i) { v0[i] = sigmoidf_(v0[i]); v1[i] = sigmoidf_(v1[i]); } }
                    v0 = v0 * sc; v1 = v1 * sc;
                    u32x4 w; w.x = cvt_pk_bf16(v0[0], v0[1]); w.y = cvt_pk_bf16(v0[2], v0[3]); w.z = cvt_pk_bf16(v1[0], v1[1]); w.w = cvt_pk_bf16(v1[2], v1[3]);
                    *(u32x4*)(rowp + bj * HALF) = w; } }
    }
};
struct EpiResF32 {
    static constexpr bool PERM = false, AFTER_DRAIN = false;
    const float* base; float* out; int ldc; float alpha;
    __device__ __forceinline__ void operator()(const f32x4 (&acc)[2][2][4][2], const Unit& u, int wr, int wc, int fr, int fq) const {
        const int col0 = u.pn * BM + wc * 32 + 4 * fq;
#pragma unroll
        for (int ai = 0; ai < 2; ++ai)
#pragma unroll
            for (int m = 0; m < 4; ++m) { const size_t off = (size_t)(u.pm * BM + ai * HALF + wr * 64 + m * 16 + fr) * ldc + col0;
#pragma unroll
                for (int bj = 0; bj < 2; ++bj)
#pragma unroll
                    for (int n = 0; n < 2; ++n) { const f32x4 bs = *(const f32x4*)(base + off + bj * HALF + n * 16); *(f32x4*)(out + off + bj * HALF + n * 16) = bs * alpha + acc[ai][bj][m][n]; } }
    }
};
struct EpiSwiGLU {
    static constexpr bool PERM = true, AFTER_DRAIN = false;
    bf16_t* O; int ldc;
    __device__ __forceinline__ void operator()(const f32x4 (&acc)[2][2][4][2], const Unit& u, int wr, int wc, int fr, int fq) const {
        const int row0 = u.pm * BM + wr * 64 + fr, col0 = u.pn * HALF + wc * 32 + 8 * fq;
#pragma unroll
        for (int ai = 0; ai < 2; ++ai)
#pragma unroll
            for (int m = 0; m < 4; ++m) { bf16_t* rowp = O + (size_t)(row0 + ai * HALF + m * 16) * ldc + col0;
                f32x4 g0 = acc[ai][0][m][0], g1 = acc[ai][0][m][1]; const f32x4 u0 = acc[ai][1][m][0], u1 = acc[ai][1][m][1];
#pragma unroll
                for (int i = 0; i < 4; ++i) { g0[i] = g0[i] * sigmoidf_(g0[i]) * u0[i]; g1[i] = g1[i] * sigmoidf_(g1[i]) * u1[i]; }
                u32x4 w; w.x = cvt_pk_bf16(g0[0], g0[1]); w.y = cvt_pk_bf16(g0[2], g0[3]); w.z = cvt_pk_bf16(g1[0], g1[1]); w.w = cvt_pk_bf16(g1[2], g1[3]);
                *(u32x4*)rowp = w; }
    }
};
template <class Epi, class Sched, bool ALIGN_EPI = false, bool SP2 = false>
__device__ __forceinline__ void gemm_phase(PG8_LAS unsigned char* lds, const Gemm g, const Sched& S, const Epi& E) {
    const int tid = threadIdx.x, wid = __builtin_amdgcn_readfirstlane(tid >> 6), lane = tid & 63, wr = wid >> 2, wc = wid & 3, fr = lane & 15, fq = lane >> 4;
    const int K = g.K, nt = K / BK;
    unsigned voffA[2], voffB[2];
#pragma unroll
    for (int i = 0; i < 2; ++i) { int R, C; stage_rc(tid * 16 + i * 8192, R, C); const int Rb = Epi::PERM ? ((R & ~31) + perm32(R & 31)) : R;
        voffA[i] = (unsigned)(R * K + C) * 2u; voffB[i] = (unsigned)(Rb * K + C) * 2u; }
    const size_t kstep = (size_t)(BK * 2);
    const size_t hstep = (size_t)HALF * K * 2;
    const size_t tstep = 2 * hstep;
    const unsigned ldsw = (unsigned)wid * 1024u;
    const int aoff = lds_byte(wr * 64 + fr, fq * 8), boff = lds_byte(wc * 32 + fr, fq * 8);
#define PG8_SA(b, h) (((b) * 2 + (h)) * HTB)
#define PG8_SB(b, h) ((4 + (b) * 2 + (h)) * HTB)
#define PG8_STAGE(bufoff, gbase, voff) do { _Pragma("unroll") for (int _i = 0; _i < 2; ++_i) \
        __builtin_amdgcn_global_load_lds((const unsigned*)((const char*)(gbase) + (voff)[_i]), (PG8_LAS unsigned*)(lds + (bufoff) + ldsw + _i * 8192), 16, 0, 0); } while (0)
#define PG8_LDA(dst, b, h) do { _Pragma("unroll") for (int m = 0; m < 4; ++m) _Pragma("unroll") for (int k = 0; k < 2; ++k) dst[m][k] = *(const PG8_LAS bf16x8*)(lds + PG8_SA(b, h) + aoff + m * 2048 + k * 1024); } while (0)
#define PG8_LDB(dst, b, h) do { _Pragma("unroll") for (int n = 0; n < 2; ++n) _Pragma("unroll") for (int k = 0; k < 2; ++k) dst[n][k] = *(const PG8_LAS bf16x8*)(lds + PG8_SB(b, h) + boff + n * 2048 + k * 1024); } while (0)
#define PG8_MMA(ai, bj, At, Bt) do { __builtin_amdgcn_s_setprio(1); _Pragma("unroll") for (int m = 0; m < 4; ++m) _Pragma("unroll") for (int n = 0; n < 2; ++n) _Pragma("unroll") for (int k = 0; k < 2; ++k) \
        acc[ai][bj][m][n] = __builtin_amdgcn_mfma_f32_16x16x32_bf16(Bt[n][k], At[m][k], acc[ai][bj][m][n], 0, 0, 0); __builtin_amdgcn_s_setprio(0); } while (0)
#define PG8_WAIT_V(n) asm volatile("s_waitcnt vmcnt(" #n ")" ::: "memory")
#define PG8_WAIT_L(n) asm volatile("s_waitcnt lgkmcnt(" #n ")" ::: "memory")
#define PG8_BAR __builtin_amdgcn_s_barrier()
#define PG8_SCHED __builtin_amdgcn_sched_barrier(0)
    Unit cur, nxt; int ui = 0;
    if (!S.next(0, cur)) return;
    f32x4 acc[2][2][4][2];
#pragma unroll
    for (int a = 0; a < 2; ++a)
#pragma unroll
        for (int b = 0; b < 2; ++b)
#pragma unroll
            for (int m = 0; m < 4; ++m)
#pragma unroll
                for (int n = 0; n < 2; ++n) acc[a][b][m][n] = (f32x4){0.f, 0.f, 0.f, 0.f};
    bf16x8 At[4][2], B0[2][2], B1[2][2];
    const char* cA = (const char*)g.A + (size_t)cur.pm * tstep; const char* cB = (const char*)g.Bt + (size_t)cur.pn * tstep;
    S.a_ready(cur);
    if constexpr (SP2) {
        PG8_STAGE(PG8_SB(0, 0), cB, voffB); PG8_STAGE(PG8_SB(0, 1), cB + hstep, voffB); PG8_STAGE(PG8_SA(0, 0), cA, voffA); PG8_STAGE(PG8_SA(0, 1), cA + hstep, voffA);
        if (wr == 1) PG8_BAR;
        PG8_WAIT_V(2); PG8_BAR;
        PG8_STAGE(PG8_SB(1, 0), cB + kstep, voffB); PG8_STAGE(PG8_SA(1, 0), cA + kstep, voffA); PG8_STAGE(PG8_SB(1, 1), cB + hstep + kstep, voffB);
        PG8_WAIT_V(6); PG8_BAR;
    } else {
        PG8_STAGE(PG8_SB(0, 0), cB, voffB); PG8_STAGE(PG8_SA(0, 0), cA, voffA); PG8_STAGE(PG8_SB(0, 1), cB + hstep, voffB); PG8_STAGE(PG8_SA(0, 1), cA + hstep, voffA);
        if (wr == 1) PG8_BAR;
        PG8_WAIT_V(4); PG8_BAR;
        PG8_STAGE(PG8_SB(1, 0), cB + kstep, voffB); PG8_STAGE(PG8_SA(1, 0), cA + kstep, voffA); PG8_STAGE(PG8_SB(1, 1), cB + hstep + kstep, voffB);
        PG8_WAIT_V(6); PG8_BAR;
    }
    for (;;) {
        const bool has_next = S.next(ui + 1, nxt);
        const char* nA = has_next ? (const char*)g.A + (size_t)nxt.pm * tstep : cA; const char* nB = has_next ? (const char*)g.Bt + (size_t)nxt.pn * tstep : cB;
        for (int t = 0; t < nt; t += 2) {
            const bool last = (t == nt - 2);
            const char* a1 = cA + (size_t)(t + 1) * kstep;
            const char* a2 = last ? nA : cA + (size_t)(t + 2) * kstep; const char* b2 = last ? nB : cB + (size_t)(t + 2) * kstep;
            const char* a3 = a2 + kstep; const char* b3 = b2 + kstep;
            if (last && has_next) S.a_ready(nxt);
            if constexpr (SP2) {
            PG8_LDB(B0, 0, 0); PG8_LDB(B1, 0, 1); PG8_SCHED; PG8_LDA(At, 0, 0); PG8_STAGE(PG8_SA(1, 1), a1 + hstep, voffA);
            PG8_WAIT_V(8); PG8_WAIT_L(0); PG8_BAR; PG8_MMA(0, 0, At, B0); PG8_MMA(0, 1, At, B1); PG8_BAR; PG8_SCHED;
            PG8_LDA(At, 0, 1); PG8_STAGE(PG8_SB(0, 0), b2, voffB); PG8_STAGE(PG8_SB(0, 1), b2 + hstep, voffB); PG8_STAGE(PG8_SA(0, 0), a2, voffA);
            PG8_WAIT_V(8); PG8_WAIT_L(0); PG8_BAR; PG8_MMA(1, 0, At, B0); PG8_MMA(1, 1, At, B1); PG8_BAR; PG8_SCHED;
            PG8_LDB(B0, 1, 0); PG8_LDB(B1, 1, 1); PG8_SCHED; PG8_LDA(At, 1, 0); PG8_STAGE(PG8_SA(0, 1), a2 + hstep, voffA);
            PG8_WAIT_V(8); PG8_WAIT_L(0); PG8_BAR; PG8_MMA(0, 0, At, B0); PG8_MMA(0, 1, At, B1); PG8_BAR; PG8_SCHED;
            PG8_LDA(At, 1, 1); PG8_STAGE(PG8_SB(1, 0), b3, voffB); PG8_STAGE(PG8_SB(1, 1), b3 + hstep, voffB); PG8_STAGE(PG8_SA(1, 0), a3, voffA);
            PG8_WAIT_V(8); PG8_WAIT_L(0); PG8_BAR; PG8_MMA(1, 0, At, B0); PG8_MMA(1, 1, At, B1); PG8_BAR; PG8_SCHED;
            } else {
            PG8_LDB(B0, 0, 0); PG8_SCHED; PG8_LDA(At, 0, 0); PG8_STAGE(PG8_SA(1, 1), a1 + hstep, voffA);
            PG8_WAIT_L(8); PG8_BAR; PG8_WAIT_L(0); PG8_MMA(0, 0, At, B0); PG8_BAR; PG8_SCHED;
            PG8_LDB(B1, 0, 1); PG8_STAGE(PG8_SB(0, 0), b2, voffB);
            PG8_BAR; PG8_WAIT_L(0); PG8_MMA(0, 1, At, B1); PG8_BAR;
            PG8_LDA(At, 0, 1); PG8_STAGE(PG8_SA(0, 0), a2, voffA);
            PG8_BAR; PG8_WAIT_L(0); PG8_MMA(1, 0, At, B0); PG8_BAR; PG8_SCHED;
            PG8_STAGE(PG8_SB(0, 1), b2 + hstep, voffB);
            PG8_WAIT_V(6); PG8_BAR; PG8_MMA(1, 1, At, B1); PG8_BAR;
            PG8_LDB(B0, 1, 0); PG8_SCHED; PG8_LDA(At, 1, 0); PG8_STAGE(PG8_SA(0, 1), a2 + hstep, voffA);
            PG8_WAIT_L(8); PG8_BAR; PG8_WAIT_L(0); PG8_MMA(0, 0, At, B0); PG8_BAR; PG8_SCHED;
            PG8_LDB(B1, 1, 1); PG8_STAGE(PG8_SB(1, 0), b3, voffB);
            PG8_BAR; PG8_WAIT_L(0); PG8_MMA(0, 1, At, B1); PG8_BAR;
            PG8_LDA(At, 1, 1); PG8_STAGE(PG8_SA(1, 0), a3, voffA);
            PG8_BAR; PG8_WAIT_L(0); PG8_MMA(1, 0, At, B0); PG8_BAR; PG8_SCHED;
            PG8_STAGE(PG8_SB(1, 1), b3 + hstep, voffB);
            PG8_WAIT_V(6); PG8_BAR; PG8_MMA(1, 1, At, B1); PG8_BAR;
            }
        }
        if constexpr (ALIGN_EPI) { if (wr == 0) PG8_BAR; }
        if constexpr (!Epi::AFTER_DRAIN) { E(acc, cur, wr, wc, fr, fq); S.done(cur); }
        if (!has_next) break;
#pragma unroll
        for (int a = 0; a < 2; ++a)
#pragma unroll
            for (int b = 0; b < 2; ++b)
#pragma unroll
                for (int m = 0; m < 4; ++m)
#pragma unroll
                    for (int n = 0; n < 2; ++n) acc[a][b][m][n] = (f32x4){0.f, 0.f, 0.f, 0.f};
        cur = nxt; cA = nA; cB = nB; ++ui;
        if constexpr (ALIGN_EPI) { if (wr == 1) PG8_BAR; }
    }
    PG8_WAIT_V(0);
    if constexpr (!ALIGN_EPI) { if (wr == 0) PG8_BAR; }
    PG8_BAR;
    if constexpr (Epi::AFTER_DRAIN) { E.fused(acc, cur, wr, wc, fr, fq, lds, wid, lane); S.done(cur); }
#undef PG8_SA
#undef PG8_SB
#undef PG8_STAGE
#undef PG8_LDA
#undef PG8_LDB
#undef PG8_MMA
#undef PG8_WAIT_V
#undef PG8_WAIT_L
#undef PG8_BAR
#undef PG8_SCHED
}
}
__device__ const float INVF_R[128] = {1.000000000e+00f, 9.300450087e-01f, 8.649836779e-01f, 8.044736385e-01f, 7.481966019e-01f, 6.958565116e-01f, 6.471778154e-01f, 6.019044518e-01f, 5.597981811e-01f, 5.206375122e-01f, 4.842162728e-01f, 4.503428936e-01f, 4.188391268e-01f, 3.895392120e-01f, 3.622889817e-01f, 3.369450271e-01f, 3.133740425e-01f, 2.914519310e-01f, 2.710633874e-01f, 2.521011233e-01f, 2.344653904e-01f, 2.180633694e-01f, 2.028087080e-01f, 1.886212230e-01f, 1.754262149e-01f, 1.631542742e-01f, 1.517407894e-01f, 1.411257535e-01f, 1.312533021e-01f, 1.220714748e-01f, 1.135319397e-01f, 1.055898219e-01f, 9.820328653e-02f, 9.133346379e-02f, 8.494423330e-02f, 7.900195569e-02f, 7.347535342e-02f, 6.833537668e-02f, 6.355497986e-02f, 5.910899118e-02f, 5.497401953e-02f, 5.112830922e-02f, 4.755162448e-02f, 4.422515258e-02f, 4.113136977e-02f, 3.825402260e-02f, 3.557796404e-02f, 3.308910504e-02f, 3.077435680e-02f, 2.862153389e-02f, 2.661931701e-02f, 2.475716174e-02f, 2.302526683e-02f, 2.141453326e-02f, 1.991648041e-02f, 1.852322184e-02f, 1.722742990e-02f, 1.602228358e-02f, 1.490144618e-02f, 1.385901403e-02f, 1.288950257e-02f, 1.198781747e-02f, 1.114920899e-02f, 1.036926545e-02f, 9.643883444e-03f, 8.969245479e-03f, 8.341802284e-03f, 7.758250926e-03f, 7.215522230e-03f, 6.710760761e-03f, 6.241309457e-03f, 5.804697983e-03f, 5.398627371e-03f, 5.020966288e-03f, 4.669724498e-03f, 4.343053792e-03f, 4.039235413e-03f, 3.756670747e-03f, 3.493872471e-03f, 3.249458736e-03f, 3.022142686e-03f, 2.810728736e-03f, 2.614103956e-03f, 2.431234345e-03f, 2.261157380e-03f, 2.102978062e-03f, 1.955864020e-03f, 1.819041790e-03f, 1.691789716e-03f, 1.573440502e-03f, 1.463370281e-03f, 1.361000235e-03f, 1.265791478e-03f, 1.177242957e-03f, 1.094888896e-03f, 1.018295996e-03f, 9.470609948e-04f, 8.808093844e-04f, 8.191923262e-04f, 7.618857198e-04f, 7.085879333e-04f, 6.590186385e-04f, 6.129170069e-04f, 5.700403708e-04f, 5.301629426e-04f, 4.930753494e-04f, 4.585822753e-04f, 4.265021416e-04f, 3.966661752e-04f, 3.689173318e-04f, 3.431097430e-04f, 3.191074939e-04f, 2.967843320e-04f, 2.760227653e-04f, 2.567135962e-04f, 2.387551940e-04f, 2.220530587e-04f, 2.065193403e-04f, 1.920722716e-04f, 1.786358480e-04f, 1.661392889e-04f, 1.545170089e-04f, 1.437077590e-04f, 1.336546848e-04f, 1.243048755e-04f, 1.156091312e-04f, 1.075216787e-04f, 9.999999747e-05f};
__device__ const float INVF_A[8] = {1.000000000e+00f, 1.939227581e-01f, 3.760603070e-02f, 7.292665076e-03f, 1.414213446e-03f, 2.742481884e-04f, 5.318296462e-05f, 1.031338525e-05f};
#define LAS __attribute__((address_space(3)))
typedef unsigned short bf16_t;
typedef short bf16x8 __attribute__((ext_vector_type(8)));
typedef short s16x4 __attribute__((ext_vector_type(4)));
typedef float f32x4 __attribute__((ext_vector_type(4)));
typedef unsigned u32x4 __attribute__((ext_vector_type(4)));
typedef unsigned u32x2 __attribute__((ext_vector_type(2)));

constexpr int NB = 2, SEQ = 4096, DM = 2048, MTOK = NB * SEQ, NIN = 12800, DFF = 5632, NGU = 2 * DFF;
constexpr int C_RQ = 0, C_RK = 1024, C_RV = 2048, C_RG = 4096, C_AQ = 6144, C_AK = 8192, C_AV = 8448, C_GA = 8704, C_GB = 10752;
constexpr float ALPHA = 1.189207115002721f, LN_EPS = 1e-5f, GN_EPS = 1e-5f;
constexpr int NWAVES = 8, NTHR = 512;
constexpr int LDS_BYTES = 147456;
constexpr size_t MiB = 1u << 20;
constexpr size_t WS_WOUT = 1 * MiB, WS_WGU = 9 * MiB, WS_WDN = 53 * MiB, WS_TABR = 75 * MiB, WS_TABA = 83 * MiB;
constexpr size_t WS_WIN = 84 * MiB, WS_XB = 134 * MiB;
constexpr size_t WS_ATT = 84 * MiB, WS_PREVT = 116 * MiB;
constexpr size_t WS_PROJ = 166 * MiB;
constexpr size_t WS_MERGED = 366 * MiB, WS_END = 398 * MiB;
constexpr size_t WS_H1 = 84 * MiB, WS_H1B = 148 * MiB, WS_ACT = 180 * MiB;
static_assert(WS_WGU + (size_t)NGU * DM * 2 <= WS_WDN && WS_WDN + (size_t)DM * DFF * 2 <= WS_TABR && WS_TABR + (size_t)MTOK * 256 * 4 <= WS_TABA && WS_TABA + (size_t)MTOK * 16 * 4 <= WS_WIN, "ws map 1");
static_assert(WS_WIN + (size_t)NIN * DM * 2 <= WS_XB && WS_XB + (size_t)MTOK * DM * 2 <= WS_PROJ && WS_PROJ + (size_t)MTOK * NIN * 2 <= WS_MERGED, "ws map 2");
static_assert(WS_PREVT + (size_t)NB * 4 * 16 * 512 * 256 * 2 <= WS_PROJ && WS_ACT + (size_t)MTOK * DFF * 2 <= WS_MERGED, "ws map 3");

__device__ const float LG2G[4] = {-4.580368961312e-02f, -2.272007650008e-02f, -1.131531322783e-02f, -5.646563141142e-03f};

__device__ __forceinline__ unsigned f2bf(float f) { unsigned u = __builtin_bit_cast(unsigned, f); return (u + 0x7fffu + ((u >> 16) & 1u)) >> 16; }
__device__ __forceinline__ unsigned pk2(float lo, float hi) { return f2bf(lo) | (f2bf(hi) << 16); }
__device__ __forceinline__ float bflo(unsigned w) { return __builtin_bit_cast(float, w << 16); }
__device__ __forceinline__ float bfhi(unsigned w) { return __builtin_bit_cast(float, w & 0xffff0000u); }
typedef float f32x2_t __attribute__((ext_vector_type(2))); typedef __bf16 bf16x2_t __attribute__((ext_vector_type(2)));
__device__ __forceinline__ unsigned cvtpk(float lo, float hi) { f32x2_t v = {lo, hi}; bf16x2_t b = __builtin_convertvector(v, bf16x2_t); return __builtin_bit_cast(unsigned, b); }
__device__ __forceinline__ f32x4 mfma16(bf16x8 a, bf16x8 b, f32x4 c) { return __builtin_amdgcn_mfma_f32_16x16x32_bf16(a, b, c, 0, 0, 0); }
typedef short v4i16_t __attribute__((ext_vector_type(4)));
__device__ __forceinline__ s16x4 tr_rd(LAS const unsigned char* p) { return __builtin_bit_cast(s16x4, __builtin_amdgcn_ds_read_tr16_b64_v4i16((LAS v4i16_t*)p)); }
__device__ __forceinline__ bf16x8 cat8(s16x4 a, s16x4 b) { return (bf16x8){a[0], a[1], a[2], a[3], b[0], b[1], b[2], b[3]}; }
__device__ __forceinline__ bf16x8 pack8(f32x4 a, f32x4 b) { u32x4 w; w.x = cvtpk(a[0], a[1]); w.y = cvtpk(a[2], a[3]); w.z = cvtpk(b[0], b[1]); w.w = cvtpk(b[2], b[3]); return __builtin_bit_cast(bf16x8, w); }
__device__ __forceinline__ float wave_sum(float v) {
#pragma unroll
    for (int o = 1; o < 64; o <<= 1) v += __shfl_xor(v, o);
    return v;
}

template <int MODE> __device__ __forceinline__ int dst_row(int c) {
    if (MODE == 1) {
        if (c < 2048) { const int j = c & 255; return (c & ~255) + ((j < 128) ? 2 * j : 2 * (j - 128) + 1); }
        if (c >= C_AQ && c < C_AV) { const int j = c & 63; if (j < 16) return (c & ~63) + ((j < 8) ? 2 * j : 2 * (j - 8) + 1); }
        return c;
    }
    if (MODE == 2) return ((c >> 7) << 8) + (c & 127);
    if (MODE == 3) return ((c >> 7) << 8) + 128 + (c & 127);
    return c;
}
template <int MODE> __device__ __forceinline__ void p0_transpose_item(const float* W, int K, int N, bf16_t* WT, LAS float* scr, int item, int lane) {
    const int nblk = N / 32, kb = item / nblk, nb = item % nblk, k0 = 64 * kb, n0 = 32 * nb;
#pragma unroll 8
    for (int i = 0; i < 32; ++i) { const int kk = 2 * i + (lane >> 5); scr[kk * 33 + (lane & 31)] = W[(size_t)(k0 + kk) * N + n0 + (lane & 31)]; }
    asm volatile("s_waitcnt lgkmcnt(0)" ::: "memory");
    const int c = lane & 7;
#pragma unroll
    for (int j = 0; j < 4; ++j) { const int n = (lane >> 3) + 8 * j; const LAS float* s = scr + (8 * c) * 33 + n;
        u32x4 o; o.x = pk2(s[0 * 33], s[1 * 33]); o.y = pk2(s[2 * 33], s[3 * 33]); o.z = pk2(s[4 * 33], s[5 * 33]); o.w = pk2(s[6 * 33], s[7 * 33]);
        *(u32x4*)(WT + (size_t)dst_row<MODE>(n0 + n) * K + k0 + 8 * c) = o; }
    asm volatile("s_waitcnt lgkmcnt(0)" ::: "memory");
}

struct Args { const float* in[14]; float* out; unsigned char* ws; int ph_lo, ph_hi; };

__device__ __forceinline__ void p0_prologue(const Args& a, LAS unsigned char* lds, int gw, int NGW, int wave, int lane, int part) {
    LAS float* scr = (LAS float*)(lds + wave * 16384);
    unsigned char* ws = a.ws;
    const float* w_in = a.in[2]; const float* w_out = a.in[6]; const float* w_gate = a.in[9]; const float* w_up = a.in[10]; const float* w_down = a.in[11];
    constexpr int I_IN = (DM / 64) * (NIN / 32), I_OUT = (DM / 64) * (DM / 32), I_G = (DM / 64) * (DFF / 32), I_D = (DFF / 64) * (DM / 32);
    constexpr int NITEMS = I_IN + I_OUT + 2 * I_G + I_D;
    const int it_lo = (part == 2) ? I_IN : (part == 3) ? NITEMS - I_D : 0, it_hi = (part == 1) ? I_IN : (part == 2) ? NITEMS - I_D : NITEMS;
    for (int it = it_lo + gw; it < it_hi; it += NGW) {
        int r = it;
        if (r < I_IN) { p0_transpose_item<1>(w_in, DM, NIN, (bf16_t*)(ws + WS_WIN), scr, r, lane); continue; } r -= I_IN;
        if (r < I_OUT) { p0_transpose_item<0>(w_out, DM, DM, (bf16_t*)(ws + WS_WOUT), scr, r, lane); continue; } r -= I_OUT;
        if (r < I_G) { p0_transpose_item<2>(w_gate, DM, DFF, (bf16_t*)(ws + WS_WGU), scr, r, lane); continue; } r -= I_G;
        if (r < I_G) { p0_transpose_item<3>(w_up, DM, DFF, (bf16_t*)(ws + WS_WGU), scr, r, lane); continue; } r -= I_G;
        p0_transpose_item<0>(w_down, DFF, DM, (bf16_t*)(ws + WS_WDN), scr, r, lane);
    }
    if (part >= 2) return;
    const float* x = a.in[0]; bf16_t* xb = (bf16_t*)(ws + WS_XB);
    for (int m = gw; m < MTOK; m += NGW) {
        const f32x4* xr = (const f32x4*)(x + (size_t)m * DM) + lane; u32x2* o = (u32x2*)(xb + (size_t)m * DM) + lane;
#pragma unroll
        for (int j = 0; j < 8; ++j) { const f32x4 v = xr[64 * j]; u32x2 w; w.x = pk2(v[0], v[1]); w.y = pk2(v[2], v[3]); o[64 * j] = w; }
    }
    const int* pos = (const int*)a.in[1]; float* tabR = (float*)(ws + WS_TABR); float* tabA = (float*)(ws + WS_TABA);
    const int gt = gw * 64 + lane, NGT = NGW * 64;
    for (int i = gt; i < MTOK * 136; i += NGT) {
        const int row = i / 136, j = i % 136; const double p = (double)pos[row];
        const double fr = (j < 128) ? (double)INVF_R[j] : (double)INVF_A[j - 128];
        double t = p * fr * 0.15915494309189535; t -= __builtin_rint(t);
        const float tf = (float)t; const float cs = __builtin_amdgcn_cosf(tf), sn = __builtin_amdgcn_sinf(tf);
        if (j < 128) { tabR[(size_t)row * 256 + j] = cs; tabR[(size_t)row * 256 + 128 + j] = sn; }
        else { tabA[(size_t)row * 16 + (j - 128)] = cs; tabA[(size_t)row * 16 + 8 + (j - 128)] = sn; }
    }
}

constexpr int SC_KP = 544, SC_VP = 160, SC_VOFF = 128 * SC_KP;
__device__ __forceinline__ void scan_item(LAS unsigned char* lds, const bf16_t* proj, bf16_t* prevT, int item) {
    const int tid = threadIdx.x, lane = tid & 63, w = __builtin_amdgcn_readfirstlane(tid >> 6), fr = lane & 15, fq = lane >> 4, q4 = (lane & 15) >> 2, p4 = lane & 3;
    const int es = item & 7, h = (item >> 3) & 3, b = item >> 5;
    const float lg = LG2G[h];
    f32x4 acc[2][4];
#pragma unroll
    for (int i = 0; i < 2; ++i)
#pragma unroll
        for (int j = 0; j < 4; ++j) acc[i][j] = (f32x4){0.f, 0.f, 0.f, 0.f};
    const bf16_t* kbase = proj + (size_t)(b * SEQ) * NIN + C_RK + 256 * h;
    const bf16_t* vbase = proj + (size_t)(b * SEQ) * NIN + C_RV + 512 * h + 64 * es;
    u32x4 krA[8], vrA[2], krB[8], vrB[2];
#define SC_LOAD(step, KR, VR) do { int tq_ = tid; asm volatile("" : "+v"(tq_)); const bf16_t* kb_ = kbase + (size_t)((step) * 128) * NIN; const bf16_t* vb_ = vbase + (size_t)((step) * 128) * NIN; \
    _Pragma("unroll") for (int j = 0; j < 8; ++j) { const int p = tq_ + 512 * j; KR[j] = *(const u32x4*)(kb_ + (unsigned)((p >> 5) * NIN + (p & 31) * 8)); } \
    _Pragma("unroll") for (int j = 0; j < 2; ++j) { const int p = tq_ + 512 * j; VR[j] = *(const u32x4*)(vb_ + (unsigned)((p >> 3) * NIN + (p & 7) * 8)); } } while (0)
#define SC_STEP(step, KR, VR) do { \
        __syncthreads(); int tq_ = tid; asm volatile("" : "+v"(tq_)); \
        _Pragma("unroll") for (int j = 0; j < 8; ++j) { const int p = tq_ + 512 * j; *(LAS u32x4*)(lds + (p >> 5) * SC_KP + (p & 31) * 16) = KR[j]; } \
        _Pragma("unroll") for (int j = 0; j < 2; ++j) { const int p = tq_ + 512 * j; const int r = p >> 3; const float dc = __builtin_amdgcn_exp2f(lg * (float)(255 - (((step) & 1) * 128 + r))); \
            u32x4 v = VR[j], o; \
            o.x = cvtpk(bflo(v.x) * dc, bfhi(v.x) * dc); o.y = cvtpk(bflo(v.y) * dc, bfhi(v.y) * dc); \
            o.z = cvtpk(bflo(v.z) * dc, bfhi(v.z) * dc); o.w = cvtpk(bflo(v.w) * dc, bfhi(v.w) * dc); \
            *(LAS u32x4*)(lds + SC_VOFF + r * SC_VP + (p & 7) * 16) = o; } \
        __syncthreads(); \
        if ((step) + 2 < 30) SC_LOAD((step) + 2, KR, VR); \
        _Pragma("unroll") for (int ks = 0; ks < 4; ++ks) { \
            const int rbase = 32 * ks + 8 * fq + q4; \
            bf16x8 af[2], bfr[4]; \
            _Pragma("unroll") for (int dt = 0; dt < 2; ++dt) { const LAS unsigned char* p = lds + rbase * SC_KP + (32 * w + 16 * dt + 4 * p4) * 2; af[dt] = cat8(tr_rd(p), tr_rd(p + 4 * SC_KP)); } \
            _Pragma("unroll") for (int et = 0; et < 4; ++et) { const LAS unsigned char* p = lds + SC_VOFF + rbase * SC_VP + (16 * et + 4 * p4) * 2; bfr[et] = cat8(tr_rd(p), tr_rd(p + 4 * SC_VP)); } \
            _Pragma("unroll") for (int dt = 0; dt < 2; ++dt) _Pragma("unroll") for (int et = 0; et < 4; ++et) acc[dt][et] = mfma16(af[dt], bfr[et], acc[dt][et]); \
        } } while (0)
    SC_LOAD(0, krA, vrA); SC_LOAD(1, krB, vrB);
    const float cd = __builtin_amdgcn_exp2f(lg * 256.0f);
    for (int n = 0; n < 15; ++n) {
        if (n > 0) {
#pragma unroll
            for (int i = 0; i < 2; ++i)
#pragma unroll
                for (int j = 0; j < 4; ++j) acc[i][j] = acc[i][j] * cd; }
        SC_STEP(2 * n, krA, vrA);
        SC_STEP(2 * n + 1, krB, vrB);
        bf16_t* ob = prevT + ((size_t)((b * 4 + h) * 16 + n + 1) * 512 + 64 * es) * 256;
#pragma unroll
        for (int dt = 0; dt < 2; ++dt)
#pragma unroll
            for (int et = 0; et < 4; ++et) { u32x2 o; o.x = cvtpk(acc[dt][et][0], acc[dt][et][1]); o.y = cvtpk(acc[dt][et][2], acc[dt][et][3]);
                *(u32x2*)(ob + (size_t)(16 * et + fr) * 256 + 32 * w + 16 * dt + 4 * fq) = o; }
    }
#undef SC_STEP
#undef SC_LOAD
    __syncthreads();
}

constexpr int AT_KP = 144, AT_VP = 160, AT_VOFF = 256 * AT_KP;
__device__ __forceinline__ void attn_item(LAS unsigned char* lds, const bf16_t* proj, const float* sinks, bf16_t* att, int item) {
    const int tid = threadIdx.x, lane = tid & 63, w = __builtin_amdgcn_readfirstlane(tid >> 6), fr = lane & 15, fq = lane >> 4, q4 = (lane & 15) >> 2, p4 = lane & 3;
    const int n = item & 31, kvh = (item >> 5) & 3, b = item >> 7;
    __syncthreads();
    {
        const long tok0 = (long)b * SEQ + 128 * (n - 1);
#pragma unroll
        for (int j = 0; j < 4; ++j) { const int p = tid + 512 * j, r = p >> 3, ch = p & 7;
            u32x4 kv = (u32x4){0u, 0u, 0u, 0u}, vv = (u32x4){0u, 0u, 0u, 0u};
            if (n > 0 || r >= 128) { const bf16_t* src = proj + (size_t)(tok0 + r) * NIN; kv = *(const u32x4*)(src + C_AK + 64 * kvh + ch * 8); vv = *(const u32x4*)(src + C_AV + 64 * kvh + ch * 8); }
            *(LAS u32x4*)(lds + r * AT_KP + ch * 16) = kv; *(LAS u32x4*)(lds + AT_VOFF + r * AT_VP + ch * 16) = vv; }
        if (tid < 160) *(LAS u32x4*)(lds + AT_VOFF + 256 * AT_VP + tid * 16) = (u32x4){0u, 0u, 0u, 0u};
    }
    __syncthreads();
    const int head = 8 * kvh + w;
    const float sink2 = sinks[head] * 1.4426950408889634f;
    for (int sb = 0; sb < 8; ++sb) {
        const size_t tok = (size_t)b * SEQ + 128 * n + 16 * sb + fr;
        bf16x8 qf[2];
#pragma unroll
        for (int s = 0; s < 2; ++s) qf[s] = *(const bf16x8*)(proj + tok * NIN + C_AQ + 64 * head + 32 * s + 8 * fq);
        f32x4 st[9];
#pragma unroll
        for (int t = 0; t < 9; ++t) { st[t] = (f32x4){0.f, 0.f, 0.f, 0.f};
#pragma unroll
            for (int s = 0; s < 2; ++s) { const bf16x8 kf = *(const LAS bf16x8*)(lds + (16 * (sb + t) + fr) * AT_KP + (32 * s + 8 * fq) * 2); st[t] = mfma16(kf, qf[s], st[t]); } }
        const int qi = 16 * sb + fr; float mx = -INFINITY;
#pragma unroll
        for (int t = 0; t < 9; ++t)
#pragma unroll
            for (int i = 0; i < 4; ++i) { const int kj = 16 * (sb + t) + 4 * fq + i, dist = 128 + qi - kj; const bool ok = (dist >= 0) && (dist < 128) && (n > 0 || kj >= 128);
                const float v = ok ? st[t][i] : -INFINITY; st[t][i] = v; mx = fmaxf(mx, v); }
        mx = fmaxf(mx, __shfl_xor(mx, 16)); mx = fmaxf(mx, __shfl_xor(mx, 32)); mx = fmaxf(mx, sink2);
        float sum = 0.f;
#pragma unroll
        for (int t = 0; t < 9; ++t)
#pragma unroll
            for (int i = 0; i < 4; ++i) { const float p = __builtin_amdgcn_exp2f(st[t][i] - mx); st[t][i] = p; sum += p; }
        sum += __shfl_xor(sum, 16); sum += __shfl_xor(sum, 32);
        const float rden = 1.0f / (sum + __builtin_amdgcn_exp2f(sink2 - mx));
        f32x4 o[4];
#pragma unroll
        for (int dt = 0; dt < 4; ++dt) o[dt] = (f32x4){0.f, 0.f, 0.f, 0.f};
#pragma unroll
        for (int ks = 0; ks < 5; ++ks) {
            const bf16x8 pf = pack8(st[2 * ks], (2 * ks + 1 < 9) ? st[(2 * ks + 1 < 9) ? 2 * ks + 1 : 8] : (f32x4){0.f, 0.f, 0.f, 0.f});
            const LAS unsigned char* vb = lds + AT_VOFF + (16 * (sb + 2 * ks) + 4 * fq + q4) * AT_VP + (4 * p4) * 2;
#pragma unroll
            for (int dt = 0; dt < 4; ++dt) { const bf16x8 vf = cat8(tr_rd(vb + dt * 32), tr_rd(vb + 16 * AT_VP + dt * 32)); o[dt] = mfma16(vf, pf, o[dt]); }
        }
        bf16_t* op = att + tok * DM + 64 * head + 4 * fq;
#pragma unroll
        for (int dt = 0; dt < 4; ++dt) { u32x2 ov; ov.x = cvtpk(o[dt][0] * rden, o[dt][1] * rden); ov.y = cvtpk(o[dt][2] * rden, o[dt][3] * rden); *(u32x2*)(op + 16 * dt) = ov; }
    }
}

constexpr int R3_P = 528, R3_VP = 1056, R3_VOFF = 32 * R3_P, R3_BUF = R3_VOFF + 32 * R3_VP;
static_assert(R3_BUF >= 64 * R3_P && 2 * R3_BUF <= 131072, "P3 LDS");
__device__ __forceinline__ void ret_item(LAS unsigned char* lds, const bf16_t* proj, const bf16_t* prevT, const bf16_t* att, const float* gn_g, const float* gn_b, bf16_t* merged, int item) {
    const int tid = threadIdx.x, lane = tid & 63, w = __builtin_amdgcn_readfirstlane(tid >> 6), fr = lane & 15, fq = lane >> 4, q4 = (lane & 15) >> 2, p4 = lane & 3;
    const int half = item & 1, n = (item >> 1) & 15, h = (item >> 5) & 3, b = item >> 7;
    const float lg = LG2G[h];
    const int c0 = 128 * half + 16 * w;
    const size_t tokc = (size_t)b * SEQ + 256 * n;
    bf16x8 qf[8];
#pragma unroll
    for (int s = 0; s < 8; ++s) qf[s] = *(const bf16x8*)(proj + (tokc + c0) * NIN + C_RQ + 256 * h + (unsigned)(fr * NIN + 32 * s + 8 * fq));
    f32x4 acc[32];
#pragma unroll
    for (int i = 0; i < 32; ++i) acc[i] = (f32x4){0.f, 0.f, 0.f, 0.f};
    u32x4 pr[6];
    const bf16_t* pT = prevT + (size_t)((b * 4 + h) * 16 + n) * 512 * 256;
    const bf16_t* kg = proj + tokc * NIN + C_RK + 256 * h;
    const bf16_t* vg = proj + tokc * NIN + C_RV + 512 * h;
#define R3_LOAD1(eb) do { int tq_ = tid; asm volatile("" : "+v"(tq_)); const bf16_t* b_ = pT + (size_t)(64 * (eb)) * 256; _Pragma("unroll") for (int j = 0; j < 4; ++j) { const int p = tq_ + 512 * j; pr[j] = *(const u32x4*)(b_ + (unsigned)((p >> 5) * 256 + (p & 31) * 8)); } } while (0)
#define R3_STORE1(buf) do { int tq_ = tid; asm volatile("" : "+v"(tq_)); _Pragma("unroll") for (int j = 0; j < 4; ++j) { const int p = tq_ + 512 * j; *(LAS u32x4*)((buf) + (p >> 5) * R3_P + (p & 31) * 16) = pr[j]; } } while (0)
#define R3_LOAD2(kb) do { int tq_ = tid; asm volatile("" : "+v"(tq_)); const bf16_t* kb_ = kg + (size_t)(32 * (kb)) * NIN; const bf16_t* vb_ = vg + (size_t)(32 * (kb)) * NIN; _Pragma("unroll") for (int j = 0; j < 2; ++j) { const int p = tq_ + 512 * j; pr[j] = *(const u32x4*)(kb_ + (unsigned)((p >> 5) * NIN + (p & 31) * 8)); } \
    _Pragma("unroll") for (int j = 0; j < 4; ++j) { const int p = tq_ + 512 * j; pr[2 + j] = *(const u32x4*)(vb_ + (unsigned)((p >> 6) * NIN + (p & 63) * 8)); } } while (0)
#define R3_STORE2(buf) do { int tq_ = tid; asm volatile("" : "+v"(tq_)); _Pragma("unroll") for (int j = 0; j < 2; ++j) { const int p = tq_ + 512 * j; *(LAS u32x4*)((buf) + (p >> 5) * R3_P + (p & 31) * 16) = pr[j]; } \
    _Pragma("unroll") for (int j = 0; j < 4; ++j) { const int p = tq_ + 512 * j; *(LAS u32x4*)((buf) + R3_VOFF + (p >> 6) * R3_VP + (p & 63) * 16) = pr[2 + j]; } } while (0)
    __syncthreads();
    if (n > 0) { R3_LOAD1(0); R3_STORE1(lds); } else { R3_LOAD2(0); R3_STORE2(lds); }
    __syncthreads();
    if (n > 0) {
#pragma unroll
        for (int eb = 0; eb < 8; ++eb) {
            LAS unsigned char* cur = lds + (eb & 1) * R3_BUF; LAS unsigned char* nxt = lds + ((eb + 1) & 1) * R3_BUF;
            if (eb < 7) R3_LOAD1(eb + 1); else R3_LOAD2(0);
#pragma unroll
            for (int et = 0; et < 4; ++et)
#pragma unroll
                for (int s = 0; s < 8; ++s) { const bf16x8 af = *(const LAS bf16x8*)(cur + (16 * et + fr) * R3_P + (32 * s + 8 * fq) * 2); acc[4 * eb + et] = mfma16(af, qf[s], acc[4 * eb + et]); if (s == 7) __builtin_amdgcn_sched_barrier(0); }
            if (eb < 7) R3_STORE1(nxt); else R3_STORE2(nxt);
            __syncthreads();
        }
        const float qd = __builtin_amdgcn_exp2f(lg * (float)(c0 + fr + 1));
#pragma unroll
        for (int i = 0; i < 32; ++i) acc[i] = acc[i] * qd;
    }
    const int nkb = 4 * (half + 1);
    for (int kb = 0; kb < nkb; ++kb) {
        LAS unsigned char* cur = lds + (kb & 1) * R3_BUF; LAS unsigned char* nxt = lds + ((kb + 1) & 1) * R3_BUF;
        if (kb + 1 < nkb) R3_LOAD2(kb + 1);
        if (32 * kb <= c0 + 15) {
            f32x4 st[2];
#pragma unroll
            for (int t = 0; t < 2; ++t) { st[t] = (f32x4){0.f, 0.f, 0.f, 0.f};
#pragma unroll
                for (int s = 0; s < 8; ++s) { const bf16x8 kf = *(const LAS bf16x8*)(cur + (16 * t + fr) * R3_P + (32 * s + 8 * fq) * 2); st[t] = mfma16(kf, qf[s], st[t]); } }
            const int c = c0 + fr;
#pragma unroll
            for (int t = 0; t < 2; ++t)
#pragma unroll
                for (int i = 0; i < 4; ++i) { const int dlt = c - (32 * kb + 16 * t + 4 * fq + i); st[t][i] = (dlt >= 0) ? st[t][i] * __builtin_amdgcn_exp2f(lg * (float)dlt) : 0.f; }
            const bf16x8 pf = pack8(st[0], st[1]);
            const LAS unsigned char* vb = cur + R3_VOFF + (4 * fq + q4) * R3_VP + (4 * p4) * 2;
#pragma unroll
            for (int et = 0; et < 32; ++et) { const bf16x8 vf = cat8(tr_rd(vb + et * 32), tr_rd(vb + 16 * R3_VP + et * 32)); acc[et] = mfma16(vf, pf, acc[et]); if ((et & 3) == 3) __builtin_amdgcn_sched_barrier(0); }
        }
        if (kb + 1 < nkb) R3_STORE2(nxt);
        __syncthreads();
    }
#undef R3_LOAD1
#undef R3_STORE1
#undef R3_LOAD2
#undef R3_STORE2
    float s1 = 0.f;
#pragma unroll
    for (int i = 0; i < 32; ++i) s1 += (acc[i][0] + acc[i][1]) + (acc[i][2] + acc[i][3]);
    s1 += __shfl_xor(s1, 16); s1 += __shfl_xor(s1, 32);
    const float mu = s1 * (1.0f / 512.0f); float s2 = 0.f;
#pragma unroll
    for (int i = 0; i < 32; ++i) { const f32x4 d = acc[i] - mu; s2 += (d[0] * d[0] + d[1] * d[1]) + (d[2] * d[2] + d[3] * d[3]); }
    s2 += __shfl_xor(s2, 16); s2 += __shfl_xor(s2, 32);
    const float rstd = 1.0f / sqrtf(s2 * (1.0f / 512.0f) + GN_EPS);
    constexpr int YP = 1040;
    int tq_ = tid; asm volatile("" : "+v"(tq_));
    const int fr2 = tq_ & 15, fq2 = (tq_ >> 4) & 3;
#pragma unroll
    for (int et = 0; et < 32; ++et) { const int col = 512 * h + 16 * et + 4 * fq2;
        const f32x4 gg = *(const f32x4*)(gn_g + col), gb = *(const f32x4*)(gn_b + col);
        const f32x4 y = (acc[et] - mu) * rstd * gg + gb;
        u32x2 o; o.x = cvtpk(y[0], y[1]); o.y = cvtpk(y[2], y[3]);
        *(LAS u32x2*)(lds + (16 * w + fr2) * YP + (16 * et + 4 * fq2) * 2) = o; if (et & 1) __builtin_amdgcn_sched_barrier(0); }
    __syncthreads();
    {
        const bf16_t* pbase = proj + (tokc + 128 * half) * NIN + 512 * h; const bf16_t* abase = att + (tokc + 128 * half) * DM + 512 * h; bf16_t* mbase = merged + (tokc + 128 * half) * DM + 512 * h;
#pragma unroll 4
        for (int j = 0; j < 16; ++j) { const int ci = tq_ + 512 * j, row = ci >> 6, ch = ci & 63;
            const unsigned po = (unsigned)(row * NIN + ch * 8), ao = (unsigned)(row * DM + ch * 8);
            const u32x4 yv = *(const LAS u32x4*)(lds + row * YP + ch * 16);
            const u32x4 sg = *(const u32x4*)(pbase + C_RG + po), ga = *(const u32x4*)(pbase + C_GA + po), gbb = *(const u32x4*)(pbase + C_GB + po), av = *(const u32x4*)(abase + ao);
            u32x4 o;
#pragma unroll
            for (int k = 0; k < 4; ++k) { const float r0 = bflo(ga[k]) * (bflo(sg[k]) * bflo(yv[k])) + bflo(gbb[k]) * bflo(av[k]), r1 = bfhi(ga[k]) * (bfhi(sg[k]) * bfhi(yv[k])) + bfhi(gbb[k]) * bfhi(av[k]); o[k] = cvtpk(r0, r1); }
            *(u32x4*)(mbase + ao) = o; }
    }
}

template <bool WB> __device__ __forceinline__ void ln_rows(const float* z, const float* g, const float* bta, float* outf, bf16_t* outb, int gw, int NGW, int lane) {
    for (int m = gw; m < MTOK; m += NGW) {
        const f32x4* zr = (const f32x4*)(z + (size_t)m * DM) + lane; f32x4 v[8]; float s = 0.f;
#pragma unroll
        for (int j = 0; j < 8; ++j) { v[j] = zr[64 * j]; s += (v[j][0] + v[j][1]) + (v[j][2] + v[j][3]); }
        const float mean = wave_sum(s) * (1.0f / DM); float s2 = 0.f;
#pragma unroll
        for (int j = 0; j < 8; ++j) { v[j] = v[j] - mean; s2 += (v[j][0] * v[j][0] + v[j][1] * v[j][1]) + (v[j][2] * v[j][2] + v[j][3] * v[j][3]); }
        const float rstd = 1.0f / sqrtf(wave_sum(s2) * (1.0f / DM) + LN_EPS);
        f32x4* of = (f32x4*)(outf + (size_t)m * DM) + lane; u32x2* ob = (u32x2*)(outb + (size_t)m * DM) + lane;
#pragma unroll
        for (int j = 0; j < 8; ++j) { const f32x4 gg = ((const f32x4*)g)[lane + 64 * j], bb = ((const f32x4*)bta)[lane + 64 * j]; const f32x4 y = v[j] * rstd * gg + bb; of[64 * j] = y;
            if (WB) { u32x2 w; w.x = pk2(y[0], y[1]); w.y = pk2(y[2], y[3]); ob[64 * j] = w; } }
    }
}

#define XB_TMO      128
#define XB_XCNT(j)  (256  + 64 * (j))
#define XB_XSUB(j)  (1280 + 64 * (j))
#define XB_XGEN(j)  (2304 + 64 * (j))
#define XB_TOP      3328
#define XB_TOPGEN   3392
#define XCD_BAR_WORDS 3456
#define XB_SPIN_CAP (1u << 18)

__device__ __forceinline__ unsigned xb_ld(unsigned* p)              { return __hip_atomic_load(p, __ATOMIC_RELAXED, __HIP_MEMORY_SCOPE_AGENT); }
__device__ __forceinline__ unsigned xb_add(unsigned* p, unsigned v) { return __hip_atomic_fetch_add(p, v, __ATOMIC_RELAXED, __HIP_MEMORY_SCOPE_AGENT); }
__device__ __forceinline__ unsigned xb_xcc_id() { return (unsigned)__builtin_amdgcn_s_getreg((3 << 11) | 20) & 0xFu; }
#define XB_SPIN(cond, bar) do { unsigned _sp = 0; while (cond) { __builtin_amdgcn_s_sleep(1); \
    if ((++_sp & 255u) == 0u) { if (xb_ld(&(bar)[XB_TMO])) break; if (_sp > XB_SPIN_CAP) { atomicAdd(&(bar)[XB_TMO], 1u); break; } } } } while (0)

struct XcdBarrier {
    unsigned* bar; unsigned x;
    volatile LAS unsigned* st;
};

__device__ __forceinline__ XcdBarrier xcd_barrier_post(unsigned* bar, volatile LAS unsigned* st) {
    XcdBarrier b; b.bar = bar; b.x = xb_xcc_id(); b.st = st;
    if (threadIdx.x == 0) (void)xb_add(&bar[XB_XCNT(b.x)], 1u);
    return b;
}
__device__ __forceinline__ void xcd_barrier_complete(unsigned* bar, unsigned x, unsigned& nloc, unsigned& nx) {
    const unsigned G = gridDim.x * gridDim.y * gridDim.z;
    unsigned sum, cnt, mine, sp = 0u;
    for (;;) {
        sum = 0u; cnt = 0u; mine = 0u;
#pragma unroll
        for (unsigned j = 0; j < 16; ++j) { const unsigned c = xb_ld(&bar[XB_XCNT(j)]); sum += c; cnt += (c > 0u) ? 1u : 0u; mine = (j == x) ? c : mine; }
        if (sum == G) break;
        __builtin_amdgcn_s_sleep(1);
        if ((++sp & 255u) == 0u) { if (xb_ld(&bar[XB_TMO])) break; if (sp > XB_SPIN_CAP) { atomicAdd(&bar[XB_TMO], 1u); break; } }
    }
    nloc = mine > 0u ? mine : 1u; nx = cnt > 0u ? cnt : 1u;
}

__device__ __forceinline__ void xcd_barrier(const XcdBarrier& b) {
    asm volatile("s_waitcnt vmcnt(0)" ::: "memory");
    __syncthreads();
    if (threadIdx.x == 0) {
        unsigned* bar = b.bar;
        __builtin_amdgcn_s_waitcnt(0);
        unsigned nloc = b.st[0], nx = b.st[1];
        if (nloc == 0u) { xcd_barrier_complete(bar, b.x, nloc, nx); b.st[0] = nloc; b.st[1] = nx; }
        const unsigned old = xb_add(&bar[XB_XSUB(b.x)], 1u);
        const unsigned gen = old / nloc;
        if (old + 1u == (gen + 1u) * nloc) {
            __builtin_amdgcn_fence(__ATOMIC_RELEASE, "agent");
            asm volatile("s_waitcnt vmcnt(0)" ::: "memory");
            const unsigned og = xb_add(&bar[XB_TOP], 1u);
            const unsigned tg = og / nx;
            if (og + 1u == (tg + 1u) * nx) xb_add(&bar[XB_TOPGEN], 1u);
            else XB_SPIN(xb_ld(&bar[XB_TOPGEN]) == tg, bar);
            __builtin_amdgcn_fence(__ATOMIC_ACQUIRE, "agent");
            xb_add(&bar[XB_XGEN(b.x)], 1u);
            asm volatile("s_waitcnt vmcnt(0)" ::: "memory");
        } else {
            XB_SPIN(xb_ld(&bar[XB_XGEN(b.x)]) == gen, bar);
            __builtin_amdgcn_fence(__ATOMIC_ACQUIRE, "agent");
            asm volatile("s_waitcnt vmcnt(0)" ::: "memory");
        }
    }
    __syncthreads();
}

#ifndef MK_PER_PHASE
#define MK_PER_PHASE 0
#endif
constexpr int N_PHASES = 9;
__global__ void __launch_bounds__(NTHR, 2) hybrid_fwd(Args args) {
    extern __shared__ __attribute__((aligned(16))) unsigned char lds_raw[];
    LAS unsigned char* lds = (LAS unsigned char*)lds_raw;
    const int tid = threadIdx.x, lane = tid & 63, wave = __builtin_amdgcn_readfirstlane(tid >> 6);
    const int G = gridDim.x, bx = blockIdx.x;
    const int gw = bx * NWAVES + wave, NGW = G * NWAVES;
    unsigned char* ws = args.ws;
    bf16_t* proj = (bf16_t*)(ws + WS_PROJ); bf16_t* attb = (bf16_t*)args.out; bf16_t* prevT = (bf16_t*)((unsigned char*)args.out + 32 * MiB); bf16_t* merged = (bf16_t*)(ws + WS_MERGED);
    float* zbuf = args.out; float* h1 = (float*)(ws + WS_H1); bf16_t* h1b = (bf16_t*)(ws + WS_H1B); bf16_t* actb = (bf16_t*)(ws + WS_ACT);
    const int lo = args.ph_lo, hi = args.ph_hi;
    volatile LAS unsigned* misc = (volatile LAS unsigned*)(lds + 131072 + 8192);
    unsigned* ctl = (unsigned*)ws;
    int vcu = bx;
#ifndef DUP_PHASE
#define DUP_PHASE -1
#endif
#ifdef PROBE_A
#define STAMP(k) do { if (tid == 0) misc[16 + (k)] = (unsigned)__builtin_amdgcn_s_memrealtime(); } while (0)
#else
#define STAMP(k) do { } while (0)
#endif
#if !MK_PER_PHASE
    if (args.ph_hi > 1000) cg::this_grid().sync();
    if (tid < 16) misc[tid] = 0u;
    __syncthreads();
    XcdBarrier xbar = xcd_barrier_post(ctl + 4096, misc + 8);
    if (tid == 0) { const unsigned x = (unsigned)__builtin_amdgcn_s_getreg((3 << 11) | 20) & 0xFu; misc[0] = x; misc[1] = __hip_atomic_fetch_add(ctl + 64 * x, 1u, __ATOMIC_RELAXED, __HIP_MEMORY_SCOPE_AGENT); }
#endif
#ifndef PH_MASK
#define PH_MASK 0x1ff
#endif
#define IN(k) ((((PH_MASK) >> (k)) & 1) && lo <= (k) && (k) < hi)
#if MK_PER_PHASE
#define GRID_BAR() do { } while (0)
#else
#define GRID_BAR() do { xcd_barrier(xbar); } while (0)
#endif
    STAMP(0);
    const bool fast = (G == 256) && !MK_PER_PHASE;
    if (IN(0)) { p0_prologue(args, lds, gw, NGW, wave, lane, fast ? 1 : 0); if (IN(1)) GRID_BAR(); }
    STAMP(1);
#if !MK_PER_PHASE
    if (tid == 0) { bool even = (G % 8 == 0); for (int j = 0; j < 16; ++j) { const unsigned c = __hip_atomic_load(ctl + 64 * j, __ATOMIC_RELAXED, __HIP_MEMORY_SCOPE_AGENT); if (c != (j < 8 ? (unsigned)G / 8u : 0u)) even = false; }
        misc[2] = even ? misc[1] * 8u + misc[0] : (unsigned)bx; }
    __syncthreads();
    vcu = (int)misc[2];
    vcu = __builtin_amdgcn_readfirstlane(vcu);
#endif
    if (IN(1)) {
        pg8::Gemm g{(const bf16_t*)(ws + WS_XB), (const bf16_t*)(ws + WS_WIN), MTOK, NIN, DM}; pg8::RoundRange S; S.S.init(MTOK, NIN, G, vcu); S.i0 = 0; S.i1 = fast ? 6 : (1 << 20); S.swap = fast;
        pg8::EpiInProj E{proj, (const float*)(ws + WS_TABR), (const float*)(ws + WS_TABA)};
        pg8::gemm_phase<pg8::EpiInProj, pg8::RoundRange, true, true>(lds, g, S, E);
        if (IN(2)) GRID_BAR();
        STAMP(2);
    }
    if (IN(2)) {
        if (!fast) { for (int it = vcu; it < 64 + 256; it += G) { if (it < 64) scan_item(lds, proj, prevT, it); else attn_item(lds, proj, args.in[5], attb, it - 64); } }
        else {
            if (vcu < 64) scan_item(lds, proj, prevT, vcu);
            else if (vcu < 128) {
                pg8::Gemm g{(const bf16_t*)(ws + WS_XB), (const bf16_t*)(ws + WS_WIN), MTOK, NIN, DM}; pg8::RoundRange S; S.S.init(MTOK, NIN, G, vcu - 64); S.i0 = 6; S.i1 = 7; S.swap = true;
                pg8::EpiInProj E{proj, (const float*)(ws + WS_TABR), (const float*)(ws + WS_TABA)};
                pg8::gemm_phase<pg8::EpiInProj, pg8::RoundRange, true, true>(lds, g, S, E);
            } else { p0_prologue(args, lds, (vcu - 128) * NWAVES + wave, 128 * NWAVES, wave, lane, 2); }
            if (vcu >= 64) attn_item(lds, proj, args.in[5], attb, vcu - 64);
            if (vcu >= 192) attn_item(lds, proj, args.in[5], attb, vcu);
        }
        if (IN(3)) GRID_BAR();
        STAMP(3);
    }
    if (IN(3)) {
        for (int rep = 0; rep < (DUP_PHASE == 3 ? 2 : 1); ++rep) { if (rep) GRID_BAR();
            for (int it = vcu; it < 256; it += G) ret_item(lds, proj, prevT, attb, args.in[3], args.in[4], merged, it);
        }
        __syncthreads();
        if (IN(4)) GRID_BAR();
        STAMP(4);
    }
    if (IN(4)) {
        pg8::Gemm g{merged, (const bf16_t*)(ws + WS_WOUT), MTOK, DM, DM}; pg8::StaticOrder S; S.init(MTOK, DM, G, vcu);
        pg8::EpiResF32 E{args.in[0], zbuf, DM, ALPHA};
        pg8::gemm_phase<pg8::EpiResF32, pg8::StaticOrder, true, true>(lds, g, S, E);
        if (IN(5)) GRID_BAR();
        STAMP(5);
    }
    if (IN(5)) { ln_rows<true>(zbuf, args.in[7], args.in[8], h1, h1b, gw, NGW, lane); if (IN(6)) GRID_BAR(); }
    STAMP(6);
    if (IN(6)) {
        pg8::Gemm g{h1b, (const bf16_t*)(ws + WS_WGU), MTOK, NGU, DM}; pg8::StaticOrder S; S.init(MTOK, NGU, G, vcu);
        pg8::EpiSwiGLU E{actb, DFF};
        pg8::gemm_phase<pg8::EpiSwiGLU, pg8::StaticOrder, true, true>(lds, g, S, E);
        if (fast && vcu >= 128) p0_prologue(args, lds, (vcu - 128) * NWAVES + wave, 128 * NWAVES, wave, lane, 3);
        if (IN(7)) GRID_BAR();
        STAMP(7);
    }
    if (IN(7)) {
        pg8::Gemm g{actb, (const bf16_t*)(ws + WS_WDN), MTOK, DM, DFF}; pg8::StaticOrder S; S.init(MTOK, DM, G, vcu);
        pg8::EpiResF32 E{h1, zbuf, DM, ALPHA};
        pg8::gemm_phase<pg8::EpiResF32, pg8::StaticOrder, true, true>(lds, g, S, E);
        if (IN(8)) GRID_BAR();
        STAMP(8);
    }
    if (IN(8)) { ln_rows<false>(zbuf, args.in[12], args.in[13], args.out, nullptr, gw, NGW, lane); }
#ifdef PROBE_A
    GRID_BAR(); STAMP(9);
    if (bx == 0) { __syncthreads();
        const float da = (float)(misc[16 + PROBE_A + 1] - misc[16 + PROBE_A]) * 0.01f, db = (float)(misc[16 + PROBE_B + 1] - misc[16 + PROBE_B]) * 0.01f;
        if (tid == 0) args.out[0] += da;
        for (int i = tid; i < 65536; i += NTHR) args.out[2048 + i] += db * (1.0f / 64.0f); }
#endif
#undef IN
#undef GRID_BAR
}

#ifndef DBG_STOP
#define DBG_STOP 0
#endif
__global__ void dbg_dump(const unsigned short* src, int pitch, float* out) {
    const size_t i = (size_t)blockIdx.x * blockDim.x + threadIdx.x;
    const size_t r = i / DM, c = i % DM;
    float acc = 0.f;
    for (size_t cc = c; cc < (size_t)pitch; cc += DM) acc += __builtin_bit_cast(float, (unsigned)src[r * pitch + cc] << 16);
    out[i] = acc;
}
extern "C" void kernel_launch(void* const* d_in, const int* in_sizes, int n_in, void* d_out, int out_size, void* d_ws, size_t ws_size, hipStream_t stream) {
    static int grid = 0;
    if (grid == 0) {
        if (n_in != 14 || in_sizes[0] != MTOK * DM || out_size != MTOK * DM || ws_size < WS_END) { fprintf(stderr, "kernel_launch: unexpected shapes / workspace (n_in %d, ws %zu, need %zu)\n", n_in, ws_size, (size_t)WS_END); grid = -1; return; }
        int dev = 0, cus = 0, per_cu = 0;
        if (hipGetDevice(&dev) != hipSuccess || hipDeviceGetAttribute(&cus, hipDeviceAttributeMultiprocessorCount, dev) != hipSuccess) { grid = -1; return; }
        if (hipFuncSetAttribute((const void*)hybrid_fwd, hipFuncAttributeMaxDynamicSharedMemorySize, LDS_BYTES) != hipSuccess) { fprintf(stderr, "kernel_launch: hipFuncSetAttribute failed\n"); grid = -1; return; }
        if (hipOccupancyMaxActiveBlocksPerMultiprocessor(&per_cu, (const void*)hybrid_fwd, NTHR, LDS_BYTES) != hipSuccess || per_cu < 1) { fprintf(stderr, "kernel_launch: occupancy query gave %d\n", per_cu); per_cu = 1; }
        (void)hipGetLastError();
        grid = cus * per_cu;
    }
    if (grid < 0) return;
    Args a{};
    for (int i = 0; i < 14; ++i) a.in[i] = (const float*)d_in[i];
    a.out = (float*)d_out; a.ws = (unsigned char*)d_ws;
#if MK_PER_PHASE
    const int np_ = DBG_STOP ? DBG_STOP + 1 : N_PHASES;
    for (int p = 0; p < np_; ++p) { a.ph_lo = p; a.ph_hi = p + 1; hipLaunchKernelGGL(hybrid_fwd, dim3(grid), dim3(NTHR), LDS_BYTES, stream, a); }
    if (DBG_STOP == 1) hipLaunchKernelGGL(dbg_dump, dim3(MTOK * DM / 256), dim3(256), 0, stream, (const unsigned short*)((unsigned char*)d_ws + WS_PROJ), NIN, (float*)d_out);
    if (DBG_STOP == 2) hipLaunchKernelGGL(dbg_dump, dim3(MTOK * DM / 256), dim3(256), 0, stream, (const unsigned short*)((unsigned char*)d_ws + WS_PREVT), DM, (float*)d_out);
    if (DBG_STOP == 3) hipLaunchKernelGGL(dbg_dump, dim3(MTOK * DM / 256), dim3(256), 0, stream, (const unsigned short*)((unsigned char*)d_ws + WS_MERGED), DM, (float*)d_out);
    if (DBG_STOP == 6) hipLaunchKernelGGL(dbg_dump, dim3(MTOK * DM / 256), dim3(256), 0, stream, (const unsigned short*)((unsigned char*)d_ws + WS_ACT), DFF, (float*)d_out);
#else
    a.ph_lo = 0; a.ph_hi = N_PHASES;
    (void)hipMemsetAsync(d_ws, 0, 65536, stream);
    void* kargs[] = {&a};
    hipError_t e = hipLaunchCooperativeKernel((const void*)hybrid_fwd, dim3(grid), dim3(NTHR), kargs, LDS_BYTES, stream);
    if (e != hipSuccess) fprintf(stderr, "cooperative launch failed: %s (grid %d)\n", hipGetErrorString(e), grid);
#endif
}
```
